# Optimizing an MI355X kernel written in HIP

```python
import math
import jax, jax.numpy as jnp
from jax import lax
import numpy as np

D_MODEL = 2048
BATCH = 1
SEQ = 8192
DEPTH = 4

HEAD_DIM = 128
A_HEADS = 8
A_WIDTH = A_HEADS * HEAD_DIM
DILATED_BRANCHES = ((128, 1), (512, 4), (2048, 16))
A_QBLOCK = 128
B_WIDTH = D_MODEL - A_WIDTH
B_GROUP = 16
B_GROUPS = B_WIDTH // B_GROUP
B_STATE = 64
DT_MIN = 1e-3
DT_MAX = 1e-1
C_HEADS = D_MODEL // HEAD_DIM
C_WIDTH = C_HEADS * HEAD_DIM
GRID_W = 64
NA_ROWS_MAX = 8
NA_COLS = 16
T5_BUCKETS = 32
T5_MAX_DISTANCE = 1024
D_FF = 4 * D_MODEL
RMS_EPS = 1e-6
NEG_INF = -1e30
N_EVEN = (DEPTH + 1) // 2
N_ODD = DEPTH // 2

kernel_name = "hybrid_dilated_s5_neighbourhood_encoder"


def rmsnorm(x, g):
    x32 = x.astype(jnp.float32)
    y = x32 * lax.rsqrt(jnp.mean(x32 * x32, axis=-1, keepdims=True) + RMS_EPS)
    return (y * g.astype(jnp.float32)).astype(x.dtype)


def t5_bucket(rel):
    half = T5_BUCKETS // 2
    max_exact = half // 2
    n = jnp.abs(rel)
    nf = jnp.maximum(n, 1).astype(jnp.float32)
    large = max_exact + (jnp.log(nf / max_exact) / math.log(T5_MAX_DISTANCE / max_exact)
                         * (half - max_exact)).astype(jnp.int32)
    large = jnp.minimum(large, half - 1)
    return jnp.where(rel > 0, half, 0) + jnp.where(n < max_exact, n, large)


def dilated_branch(q, k, v, t5_table, window, dilation):
    b, h, s, hd = q.shape
    half = window // (2 * dilation)
    L = s // dilation
    nb = -(-L // A_QBLOCK)
    lp = nb * A_QBLOCK
    kb_len = A_QBLOCK + 2 * half
    scale = 1.0 / math.sqrt(hd)

    def strided(t):
        return t.reshape(b, h, L, dilation, hd).transpose(0, 1, 3, 2, 4)

    qs = jnp.pad(strided(q), ((0, 0), (0, 0), (0, 0), (0, lp - L), (0, 0)))
    qs = qs.reshape(b, h, dilation, nb, A_QBLOCK, hd)
    pad_k = ((0, 0), (0, 0), (0, 0), (half, lp - L + half), (0, 0))
    key_idx = jnp.arange(nb)[:, None] * A_QBLOCK + jnp.arange(kb_len)[None, :]
    ks = jnp.pad(strided(k), pad_k)[:, :, :, key_idx]
    vs = jnp.pad(strided(v), pad_k)[:, :, :, key_idx]

    off = jnp.arange(kb_len)[None, :] - half - jnp.arange(A_QBLOCK)[:, None]
    bias = jnp.transpose(t5_table[t5_bucket(off * dilation)], (2, 0, 1)).astype(jnp.float32)
    key_pos = key_idx - half
    valid = (jnp.abs(off) <= half)[None] & ((key_pos >= 0) & (key_pos < L))[:, None, :]

    sc = jnp.einsum('bhrnqc,bhrnkc->bhrnqk', qs, ks) * scale + bias[None, :, None, None]
    sc = jnp.where(valid, sc, NEG_INF)
    m = sc.max(axis=-1)
    p = jnp.exp(sc - m[..., None])
    l = p.sum(axis=-1)
    num = jnp.einsum('bhrnqk,bhrnkc->bhrnqc', p, vs)

    def unstride(t):
        t = t.reshape(b, h, dilation, lp, *t.shape[5:])[:, :, :, :L]
        t = jnp.moveaxis(t, 2, 3)
        return t.reshape(b, h, s, *t.shape[4:])

    return unstride(m), unstride(l), unstride(num)


def dilated_attention(q, k, v, t5_table):
    outs = [dilated_branch(q, k, v, t5_table, w, d) for (w, d) in DILATED_BRANCHES]
    m = jnp.stack([o[0] for o in outs])
    l = jnp.stack([o[1] for o in outs])
    num = jnp.stack([o[2] for o in outs])
    wgt = jnp.exp(m - m.max(axis=0, keepdims=True))
    return (wgt[..., None] * num).sum(0) / (wgt * l).sum(0)[..., None]


def s5_direction(u, lam_re, lam_im, log_step, b_re, b_im, c_re, c_im, reverse):
    f32 = jnp.float32
    step = jnp.exp(log_step.astype(f32))[:, None]
    lr = jnp.minimum(lam_re.astype(f32), -1e-4)
    li = lam_im.astype(f32)
    mag = jnp.exp(lr * step)
    ab_re = mag * jnp.cos(li * step)
    ab_im = mag * jnp.sin(li * step)
    den = lr * lr + li * li
    zr = ((ab_re - 1.0) * lr + ab_im * li) / den
    zi = (ab_im * lr - (ab_re - 1.0) * li) / den
    br = b_re.astype(f32)
    bi = b_im.astype(f32)
    bb_re = zr[..., None] * br - zi[..., None] * bi
    bb_im = zr[..., None] * bi + zi[..., None] * br
    bu_re = jnp.einsum('bsgc,gpc->bsgp', u, bb_re)
    bu_im = jnp.einsum('bsgc,gpc->bsgp', u, bb_im)
    a_re = jnp.broadcast_to(ab_re, bu_re.shape)
    a_im = jnp.broadcast_to(ab_im, bu_im.shape)

    def combine(e1, e2):
        a1r, a1i, b1r, b1i = e1
        a2r, a2i, b2r, b2i = e2
        return (a2r * a1r - a2i * a1i,
                a2r * a1i + a2i * a1r,
                a2r * b1r - a2i * b1i + b2r,
                a2r * b1i + a2i * b1r + b2i)

    _, _, xr, xi = lax.associative_scan(combine, (a_re, a_im, bu_re, bu_im), reverse=reverse, axis=1)
    return (jnp.einsum('bsgp,gcp->bsgc', xr, c_re.astype(f32))
            - jnp.einsum('bsgp,gcp->bsgc', xi, c_im.astype(f32)))


def neighbourhood_attention(q, k, v, rpb):
    b, h, s, hd = q.shape
    rows = s // GRID_W
    kr = min(NA_ROWS_MAX, rows)
    scale = 1.0 / math.sqrt(hd)
    r = jnp.arange(rows)
    c = jnp.arange(GRID_W)
    row_start = jnp.clip(r - kr // 2, 0, rows - kr)
    row_idx = row_start[:, None] + jnp.arange(kr)[None, :]
    col_start = jnp.clip(c - NA_COLS // 2, 0, GRID_W - NA_COLS)
    col_ok = (c[None, :] >= col_start[:, None]) & (c[None, :] < col_start[:, None] + NA_COLS)
    col_off = c[None, :] - c[:, None]
    row_off = row_idx - r[:, None]

    qg = q.reshape(b, h, rows, GRID_W, hd)
    kg = k.reshape(b, h, rows, GRID_W, hd)[:, :, row_idx]
    vg = v.reshape(b, h, rows, GRID_W, hd)[:, :, row_idx]
    bias = rpb[:, (row_off + NA_ROWS_MAX - 1)[:, None, :, None],
               jnp.clip(col_off + NA_COLS - 1, 0, 2 * NA_COLS - 2)[None, :, None, :]]
    sc = jnp.einsum('bhrqc,bhrjkc->bhrqjk', qg, kg) * scale + bias[None].astype(jnp.float32)
    sc = jnp.where(col_ok[:, None, :], sc, NEG_INF)
    p = jax.nn.softmax(sc.reshape(b, h, rows, GRID_W, kr * GRID_W), axis=-1).reshape(sc.shape)
    o = jnp.einsum('bhrqjk,bhrjkc->bhrqc', p, vg)
    return o.reshape(b, h, s, hd)


def mixer_ab(xn, w_in, w_out, t5_table, lam_re, lam_im, log_step, b_re, b_im, c_re, c_im, d_skip, w_glu):
    b, s, _ = xn.shape
    f32 = jnp.float32
    proj = xn @ w_in
    q, k, v, u = jnp.split(proj, [A_WIDTH, 2 * A_WIDTH, 3 * A_WIDTH], axis=-1)

    def heads(t):
        return t.astype(f32).reshape(b, s, A_HEADS, HEAD_DIM).transpose(0, 2, 1, 3)

    o_a = dilated_attention(heads(q), heads(k), heads(v), t5_table)
    o_a = o_a.transpose(0, 2, 1, 3).reshape(b, s, A_WIDTH)

    ug = u.astype(f32).reshape(b, s, B_GROUPS, B_GROUP)
    y = (s5_direction(ug, lam_re[0], lam_im[0], log_step[0], b_re, b_im, c_re[0], c_im[0], False)
         + s5_direction(ug, lam_re[1], lam_im[1], log_step[1], b_re, b_im, c_re[1], c_im[1], True)
         + d_skip.astype(f32).reshape(B_GROUPS, B_GROUP) * ug)
    y = jax.nn.gelu(y.reshape(b, s, B_WIDTH))
    o_b = y * jax.nn.sigmoid((y.astype(xn.dtype) @ w_glu).astype(f32))
    merged = jnp.concatenate([o_a, o_b], axis=-1).astype(xn.dtype)
    return merged @ w_out


def mixer_c(xn, w_qkv, w_out, rpb):
    b, s, _ = xn.shape
    q, k, v = jnp.split(xn @ w_qkv, 3, axis=-1)

    def heads(t):
        return t.astype(jnp.float32).reshape(b, s, C_HEADS, HEAD_DIM).transpose(0, 2, 1, 3)

    o = neighbourhood_attention(heads(q), heads(k), heads(v), rpb)
    o = o.transpose(0, 2, 1, 3).reshape(b, s, C_WIDTH).astype(xn.dtype)
    return o @ w_out


def squared_relu_mlp(xn, w1, w2):
    hdn = jnp.square(jax.nn.relu(xn @ w1))
    return hdn @ w2


def setup_inputs(seed: int = 0) -> dict:
    key = jax.random.key(seed)
    ks = jax.random.split(key, 22)
    f32 = jnp.float32
    nrm = lambda k, shape, sc: (jax.random.normal(k, shape, f32) * sc)
    lam_im_init = jnp.pi * jnp.arange(B_STATE, dtype=f32)
    return {
        "x": nrm(ks[0], (BATCH, SEQ, D_MODEL), 1.0),
        "t5_bias": nrm(ks[1], (T5_BUCKETS, A_HEADS), 0.5),
        "ab_w_in": nrm(ks[2], (N_EVEN, D_MODEL, 3 * A_WIDTH + B_WIDTH), D_MODEL ** -0.5),
        "ab_w_out": nrm(ks[3], (N_EVEN, A_WIDTH + B_WIDTH, D_MODEL), (A_WIDTH + B_WIDTH) ** -0.5),
        "s5_lam_re": -0.5 + nrm(ks[4], (N_EVEN, 2, B_GROUPS, B_STATE), 0.01),
        "s5_lam_im": lam_im_init + nrm(ks[5], (N_EVEN, 2, B_GROUPS, B_STATE), 0.01),
        "s5_log_step": jax.random.uniform(ks[6], (N_EVEN, 2, B_GROUPS), f32,
                                          minval=math.log(DT_MIN), maxval=math.log(DT_MAX)),
        "s5_b_re": nrm(ks[7], (N_EVEN, B_GROUPS, B_STATE, B_GROUP), (2 * B_GROUP) ** -0.5),
        "s5_b_im": nrm(ks[8], (N_EVEN, B_GROUPS, B_STATE, B_GROUP), (2 * B_GROUP) ** -0.5),
        "s5_c_re": nrm(ks[9], (N_EVEN, 2, B_GROUPS, B_GROUP, B_STATE), (2 * B_STATE) ** -0.5),
        "s5_c_im": nrm(ks[10], (N_EVEN, 2, B_GROUPS, B_GROUP, B_STATE), (2 * B_STATE) ** -0.5),
        "s5_d": nrm(ks[11], (N_EVEN, B_WIDTH), 1.0),
        "s5_w_glu": nrm(ks[12], (N_EVEN, B_WIDTH, B_WIDTH), B_WIDTH ** -0.5),
        "c_w_qkv": nrm(ks[13], (N_ODD, D_MODEL, 3 * C_WIDTH), D_MODEL ** -0.5),
        "c_w_out": nrm(ks[14], (N_ODD, C_WIDTH, D_MODEL), C_WIDTH ** -0.5),
        "c_rpb": nrm(ks[15], (N_ODD, C_HEADS, 2 * NA_ROWS_MAX - 1, 2 * NA_COLS - 1), 0.5),
        "norm_mix": 1.0 + nrm(ks[16], (DEPTH, D_MODEL), 0.02),
        "norm_mlp": 1.0 + nrm(ks[17], (DEPTH, D_MODEL), 0.02),
        "mlp_w1": nrm(ks[18], (DEPTH, D_MODEL, D_FF), D_MODEL ** -0.5),
        "mlp_w2": nrm(ks[19], (DEPTH, D_FF, D_MODEL), D_FF ** -0.5),
        "norm_final": 1.0 + nrm(ks[20], (D_MODEL,), 0.02),
    }


def reference(x, t5_bias, ab_w_in, ab_w_out, s5_lam_re, s5_lam_im, s5_log_step, s5_b_re, s5_b_im,
              s5_c_re, s5_c_im, s5_d, s5_w_glu, c_w_qkv, c_w_out, c_rpb, norm_mix, norm_mlp,
              mlp_w1, mlp_w2, norm_final):
    for i in range(DEPTH):
        j = i // 2
        hn = rmsnorm(x, norm_mix[i])
        if i % 2 == 0:
            mix = mixer_ab(hn, ab_w_in[j], ab_w_out[j], t5_bias, s5_lam_re[j], s5_lam_im[j],
                           s5_log_step[j], s5_b_re[j], s5_b_im[j], s5_c_re[j], s5_c_im[j],
                           s5_d[j], s5_w_glu[j])
        else:
            mix = mixer_c(hn, c_w_qkv[j], c_w_out[j], c_rpb[j])
        x = x + mix.astype(x.dtype)
        hn = rmsnorm(x, norm_mlp[i])
        x = x + squared_relu_mlp(hn, mlp_w1[i], mlp_w2[i]).astype(x.dtype)
    return rmsnorm(x, norm_final)
```

```cpp
#include <hip/hip_runtime.h>
#include <hip/hip_cooperative_groups.h>
#include <cstdio>
namespace cg = cooperative_groups;

#define LAS __attribute__((address_space(3)))
typedef unsigned short bf16_t;
typedef short bf16x8 __attribute__((ext_vector_type(8)));
typedef short s16x4 __attribute__((ext_vector_type(4)));
typedef float f32x4 __attribute__((ext_vector_type(4)));
typedef float f32x2 __attribute__((ext_vector_type(2)));
typedef unsigned u32x4 __attribute__((ext_vector_type(4)));
typedef unsigned u32x2 __attribute__((ext_vector_type(2)));

constexpr int SEQ = 8192, DM = 2048, DFF = 8192;
constexpr float RMS_EPS = 1e-6f;
constexpr int NTHR = 512;

constexpr size_t SZ_WIN = (size_t)4096 * 2048 * 2, SZ_WOUT = (size_t)2048 * 2048 * 2, SZ_GLU = (size_t)1024 * 1024 * 2;
constexpr size_t SZ_QKV = (size_t)6144 * 2048 * 2, SZ_W1 = (size_t)8192 * 2048 * 2, SZ_W2 = SZ_W1;
constexpr size_t SZ_B3 = (size_t)64 * 512 * 768 * 2, SZ_B1 = (size_t)64 * 256 * 512 * 2;
constexpr size_t WS_CTRL = 0;
constexpr size_t WS_WIN = 16384;
constexpr size_t WS_WOUT = WS_WIN + 2 * SZ_WIN;
constexpr size_t WS_GLU = WS_WOUT + 2 * SZ_WOUT;
constexpr size_t WS_QKV = WS_GLU + 2 * SZ_GLU;
constexpr size_t WS_COUT = WS_QKV + 2 * SZ_QKV;
constexpr size_t WS_W1 = WS_COUT + 2 * SZ_WOUT;
constexpr size_t WS_W2 = WS_W1 + 4 * SZ_W1;
constexpr size_t WS_B3 = WS_W2 + 4 * SZ_W2;
constexpr size_t WS_B1 = WS_B3 + 2 * SZ_B3;
constexpr size_t WS_X = WS_B1 + 2 * SZ_B1;
constexpr size_t WS_XG = WS_X + (size_t)SEQ * DM * 4;
constexpr size_t WS_Q = WS_XG + (size_t)SEQ * DM * 2;
constexpr size_t WS_K = WS_Q + (size_t)SEQ * DM * 2;
constexpr size_t WS_V = WS_K + (size_t)SEQ * DM * 2;
constexpr size_t WS_U2 = WS_V + (size_t)SEQ * DM * 2;
constexpr size_t WS_Z = WS_U2 + (size_t)64 * 256 * 768 * 2;
constexpr size_t WS_Y = WS_Z + (size_t)64 * 256 * 256 * 4;
constexpr size_t WS_MG = WS_Y + (size_t)SEQ * 1024 * 2;
constexpr size_t WS_H = WS_MG + (size_t)SEQ * DM * 2;
constexpr size_t WS_NUM = WS_H;
constexpr size_t WS_ML = WS_H + (size_t)SEQ * DFF * 2;
constexpr size_t WS_SSQ = WS_ML + (size_t)3 * 8 * SEQ * 8;
constexpr size_t WS_A32 = WS_SSQ + (size_t)9 * SEQ * 32 * 4;
constexpr size_t WS_END = WS_A32 + (size_t)2 * 2 * 64 * 64 * 8;

struct Params { const float* in[21]; float* out; unsigned char* ws; int coop; int pad; };

__device__ __forceinline__ unsigned cvt_pk_bf16(float lo, float hi) { unsigned r; asm volatile("v_cvt_pk_bf16_f32 %0, %1, %2" : "=v"(r) : "v"(lo), "v"(hi)); return r; }
__device__ __forceinline__ unsigned cvt_pk_bf16_t(float lo, float hi) { unsigned r; asm volatile("s_nop 1\n\tv_cvt_pk_bf16_f32 %0, %1, %2" : "=v"(r) : "v"(lo), "v"(hi)); return r; }
__device__ __forceinline__ unsigned cvt_pk_sw(float lo, float hi) { unsigned a = __float_as_uint(lo), b = __float_as_uint(hi); a += 0x7fffu + ((a >> 16) & 1u); b += 0x7fffu + ((b >> 16) & 1u); return (a >> 16) | (b & 0xffff0000u); }
__device__ __forceinline__ float bf_lo(unsigned w) { return __uint_as_float(w << 16); }
__device__ __forceinline__ float bf_hi(unsigned w) { return __uint_as_float(w & 0xffff0000u); }

__device__ __forceinline__ float row_rstd(const float* ssqp, int row) {
    const f32x4* p = (const f32x4*)(ssqp + (size_t)row * 32); f32x4 a = p[0];
#pragma unroll
    for (int i = 1; i < 8; ++i) a += p[i];
    return rsqrtf(((a[0] + a[1]) + (a[2] + a[3])) * (1.0f / DM) + RMS_EPS);
}
constexpr int BM = 256, BK = 64, HALF = 128, HTB = HALF * BK * 2, STAGE_BYTES = 8 * HTB, NXCD = 8, WGM = 8;
__device__ __forceinline__ int lds_byte(int r, int c) { const int st = (r >> 4) * 2 + (c >> 5), rr = r & 15, cc = c & 31, ob = rr * 64 + cc * 2; return st * 1024 + (ob ^ (((ob >> 9) & 1) << 5)); }
__device__ __forceinline__ void stage_rc(int b, int& R, int& C) { const int st = b / 1024, sb = b % 1024, swz = sb ^ (((sb >> 9) & 1) << 5); R = (st >> 1) * 16 + swz / 64; C = (st & 1) * 32 + (swz % 64) / 2; }
__device__ __forceinline__ int perm32(int rho) { const int n = rho >> 4, i = rho & 15; return 8 * (i >> 2) + 4 * n + (i & 3); }

struct Unit { int pm, pn; };
struct Gemm { const bf16_t* A; const bf16_t* Bt; int lda, ldb, K; };

struct StaticOrder {
    int nM, nN, nwg, G, c;
    __device__ void init(int M, int N, int G_, int c_) { nM = M / BM; nN = N / BM; nwg = nM * nN; G = G_; c = c_; }
    __device__ bool next(int i, Unit& u) const {
        const long L = (long)i * G + c; if (L >= nwg) return false;
        int wgid = (int)L; { const int q = nwg / NXCD, r = nwg % NXCD, xcd = wgid % NXCD, off = wgid / NXCD; wgid = (xcd < r ? xcd * (q + 1) : r * (q + 1) + (xcd - r) * q) + off; }
        const int nig = WGM * nN, gid = wgid / nig, fm = gid * WGM, gsz = (nM - fm) < WGM ? (nM - fm) : WGM;
        u.pm = fm + ((wgid % nig) % gsz); u.pn = (wgid % nig) / gsz; return true;
    }
};
struct ListOrder {
    int total, G, c, mode;
    __device__ bool next(int i, Unit& u) const {
        if (mode == 2) { if (c >= G || i >= 2) return false; u.pm = c; u.pn = 2 * c + i; return true; }
        const int L = i * G + c; if (c >= G || L >= total) return false; if (mode == 0) { u.pm = L; u.pn = L; } else { u.pm = L >> 1; u.pn = L; } return true; }
};


struct EpiIn {
    static constexpr bool PERM = true, NEEDS_RSTD = true;
    bf16_t* Q; bf16_t* K; bf16_t* V; bf16_t* U2; const float* ssq; int shift, ldq;
    __device__ __forceinline__ void operator()(const f32x4 (&acc)[2][2][4][2], const Unit& u, int ui, const LAS float* rtab, int wr, int wc, int fr, int fq) const {
        const int row0 = u.pm * BM + wr * 64 + fr; const int colt = u.pn * BM; const int t = colt >> shift; const int lc0 = (colt & ((1 << shift) - 1)) + wc * 32 + 8 * fq;
        bf16_t* base = (t == 0) ? Q : ((t == 1) ? K : V);
#pragma unroll
        for (int ai = 0; ai < 2; ++ai)
#pragma unroll
            for (int m = 0; m < 4; ++m) {
                const int row = row0 + ai * HALF + m * 16; const float rs = rtab[ui * 256 + wr * 64 + fr + ai * HALF + m * 16];
#pragma unroll
                for (int bj = 0; bj < 2; ++bj) {
                    const int lc = lc0 + bj * HALF; const f32x4 v0 = acc[ai][bj][m][0] * rs, v1 = acc[ai][bj][m][1] * rs;
                    u32x4 w; w.x = cvt_pk_bf16(v0[0], v0[1]); w.y = cvt_pk_bf16(v0[2], v0[3]); w.z = cvt_pk_bf16(v1[0], v1[1]); w.w = cvt_pk_bf16(v1[2], v1[3]);
                    if (t < 3) *(u32x4*)(base + (size_t)row * ldq + lc) = w;
                    else { const int g = lc >> 4, c = lc & 15, n = row >> 5, tt = row & 31; *(u32x4*)(U2 + ((size_t)(g * 256 + n) * 768 + tt * 16 + c)) = w; }
                }
            }
    }
};
struct EpiRes {
    static constexpr bool PERM = true, NEEDS_RSTD = false;
    bf16_t* XB; float* ssq_next;
    __device__ __forceinline__ void operator()(const f32x4 (&acc)[2][2][4][2], const Unit& u, int ui, const LAS float* rtab, int wr, int wc, int fr, int fq) const {
        const int row0 = u.pm * BM + wr * 64 + fr, col0 = u.pn * BM + wc * 32 + 8 * fq;
#pragma unroll
        for (int ai = 0; ai < 2; ++ai) {
            u32x4 xv[4][2];
#pragma unroll
            for (int m = 0; m < 4; ++m)
#pragma unroll
                for (int bj = 0; bj < 2; ++bj) xv[m][bj] = *(const u32x4*)(XB + (size_t)(row0 + ai * HALF + m * 16) * DM + col0 + bj * HALF);
#pragma unroll
            for (int m = 0; m < 4; ++m) { const int row = row0 + ai * HALF + m * 16; float ss = 0.f;
#pragma unroll
                for (int bj = 0; bj < 2; ++bj) {
                    const f32x4 a0 = acc[ai][bj][m][0], a1 = acc[ai][bj][m][1]; const u32x4 xo = xv[m][bj]; u32x4 w;
                    w.x = cvt_pk_bf16(bf_lo(xo.x) + a0[0], bf_hi(xo.x) + a0[1]); w.y = cvt_pk_bf16(bf_lo(xo.y) + a0[2], bf_hi(xo.y) + a0[3]);
                    w.z = cvt_pk_bf16(bf_lo(xo.z) + a1[0], bf_hi(xo.z) + a1[1]); w.w = cvt_pk_bf16(bf_lo(xo.w) + a1[2], bf_hi(xo.w) + a1[3]);
                    *(u32x4*)(XB + (size_t)row * DM + col0 + bj * HALF) = w;
#pragma unroll
                    for (int e = 0; e < 4; ++e) { const float lo = bf_lo(w[e]), hi = bf_hi(w[e]); ss += lo * lo + hi * hi; }
                }
                ss += __shfl_xor(ss, 16); ss += __shfl_xor(ss, 32);
                if (fq == 0) ssq_next[(size_t)row * 32 + (u.pn & 7) * 4 + wc] = ss; }
        }
    }
};
struct EpiH {
    static constexpr bool PERM = true, NEEDS_RSTD = true;
    bf16_t* H; const float* ssq;
    __device__ __forceinline__ void operator()(const f32x4 (&acc)[2][2][4][2], const Unit& u, int ui, const LAS float* rtab, int wr, int wc, int fr, int fq) const {
        const int row0 = u.pm * BM + wr * 64 + fr, col0 = u.pn * BM + wc * 32 + 8 * fq;
#pragma unroll
        for (int ai = 0; ai < 2; ++ai)
#pragma unroll
            for (int m = 0; m < 4; ++m) {
                const int row = row0 + ai * HALF + m * 16; const float rs = rtab[ui * 256 + wr * 64 + fr + ai * HALF + m * 16];
#pragma unroll
                for (int bj = 0; bj < 2; ++bj) {
                    f32x4 v0 = acc[ai][bj][m][0] * rs, v1 = acc[ai][bj][m][1] * rs;
#pragma unroll
                    for (int e = 0; e < 4; ++e) { const float a = fmaxf(v0[e], 0.f), b = fmaxf(v1[e], 0.f); v0[e] = a * a; v1[e] = b * b; }
                    u32x4 w; w.x = cvt_pk_bf16(v0[0], v0[1]); w.y = cvt_pk_bf16(v0[2], v0[3]); w.z = cvt_pk_bf16(v1[0], v1[1]); w.w = cvt_pk_bf16(v1[2], v1[3]);
                    *(u32x4*)(H + (size_t)row * DFF + col0 + bj * HALF) = w;
                }
            }
    }
};
struct EpiGlu {
    static constexpr bool PERM = true, NEEDS_RSTD = false;
    const bf16_t* Y; bf16_t* MG;
    __device__ __forceinline__ void operator()(const f32x4 (&acc)[2][2][4][2], const Unit& u, int ui, const LAS float* rtab, int wr, int wc, int fr, int fq) const {
        const int row0 = u.pm * BM + wr * 64 + fr, col0 = u.pn * BM + wc * 32 + 8 * fq;
#pragma unroll
        for (int ai = 0; ai < 2; ++ai)
#pragma unroll
            for (int m = 0; m < 4; ++m) {
                const int row = row0 + ai * HALF + m * 16;
#pragma unroll
                for (int bj = 0; bj < 2; ++bj) {
                    const int col = col0 + bj * HALF; const u32x4 yv = *(const u32x4*)(Y + (size_t)row * 1024 + col);
                    const f32x4 a0 = acc[ai][bj][m][0], a1 = acc[ai][bj][m][1]; float o[8];
                    const float yy[8] = {bf_lo(yv.x), bf_hi(yv.x), bf_lo(yv.y), bf_hi(yv.y), bf_lo(yv.z), bf_hi(yv.z), bf_lo(yv.w), bf_hi(yv.w)};
#pragma unroll
                    for (int e = 0; e < 4; ++e) { o[e] = yy[e] / (1.0f + __expf(-a0[e])); o[4 + e] = yy[4 + e] / (1.0f + __expf(-a1[e])); }
                    u32x4 w; w.x = cvt_pk_bf16(o[0], o[1]); w.y = cvt_pk_bf16(o[2], o[3]); w.z = cvt_pk_bf16(o[4], o[5]); w.w = cvt_pk_bf16(o[6], o[7]);
                    *(u32x4*)(MG + (size_t)row * DM + 1024 + col) = w;
                }
            }
    }
};
struct EpiP1 {
    static constexpr bool PERM = false, NEEDS_RSTD = false;
    float* Z;
    __device__ __forceinline__ void operator()(const f32x4 (&acc)[2][2][4][2], const Unit& u, int ui, const LAS float* rtab, int wr, int wc, int fr, int fq) const {
        const int row0 = u.pm * BM + wr * 64 + fr, col0 = wc * 32 + 4 * fq;
#pragma unroll
        for (int ai = 0; ai < 2; ++ai)
#pragma unroll
            for (int m = 0; m < 4; ++m) { float* rowp = Z + (size_t)(row0 + ai * HALF + m * 16) * 256 + col0;
#pragma unroll
                for (int bj = 0; bj < 2; ++bj)
#pragma unroll
                    for (int n = 0; n < 2; ++n) *(f32x4*)(rowp + bj * HALF + n * 16) = acc[ai][bj][m][n]; }
    }
};
__device__ __forceinline__ float gelu_tanh(float x) { const float z = 0.7978845608f * (x + 0.044715f * x * x * x); const float th = 1.0f - 2.0f / (__expf(2.0f * z) + 1.0f); return 0.5f * x * (1.0f + th); }
struct EpiP3 {
    static constexpr bool PERM = true, NEEDS_RSTD = false;
    bf16_t* Y;
    __device__ __forceinline__ void operator()(const f32x4 (&acc)[2][2][4][2], const Unit& u, int ui, const LAS float* rtab, int wr, int wc, int fr, int fq) const {
        const int g = u.pm; const int n0 = wr * 64 + fr; const int lc0 = (u.pn & 1) * 256 + wc * 32 + 8 * fq;
#pragma unroll
        for (int ai = 0; ai < 2; ++ai)
#pragma unroll
            for (int m = 0; m < 4; ++m) {
                const int n = n0 + ai * HALF + m * 16;
#pragma unroll
                for (int bj = 0; bj < 2; ++bj) {
                    const int lc = lc0 + bj * HALF, t = lc >> 4, co = lc & 15; const int token = n * 32 + t;
                    const f32x4 a0 = acc[ai][bj][m][0], a1 = acc[ai][bj][m][1];
                    u32x4 w; w.x = cvt_pk_bf16(gelu_tanh(a0[0]), gelu_tanh(a0[1])); w.y = cvt_pk_bf16(gelu_tanh(a0[2]), gelu_tanh(a0[3]));
                    w.z = cvt_pk_bf16(gelu_tanh(a1[0]), gelu_tanh(a1[1])); w.w = cvt_pk_bf16(gelu_tanh(a1[2]), gelu_tanh(a1[3]));
                    *(u32x4*)(Y + (size_t)token * 1024 + 16 * g + co) = w;
                }
            }
    }
};

template <class Epi, class Sched>
__device__ __forceinline__ void gemm_phase(LAS unsigned char* lds, const Gemm g, const Sched& S, const Epi& E) {
    int tid = threadIdx.x; asm volatile("" : "+v"(tid));
    const int wid = __builtin_amdgcn_readfirstlane(tid >> 6), lane = tid & 63, wr = wid >> 2, wc = wid & 3, fr = lane & 15, fq = lane >> 4;
    const int K = g.K, nt = K / BK;
    unsigned voffA[2], voffB[2];
#pragma unroll
    for (int i = 0; i < 2; ++i) { int R, C; stage_rc(tid * 16 + i * 8192, R, C); const int Rb = Epi::PERM ? ((R & ~31) + perm32(R & 31)) : R;
        voffA[i] = (unsigned)(R * g.lda + C) * 2u; voffB[i] = (unsigned)(Rb * g.ldb + C) * 2u; }
    const size_t kstep = (size_t)(BK * 2);
    const size_t hstepA = (size_t)HALF * g.lda * 2, hstepB = (size_t)HALF * g.ldb * 2;
    const size_t tstepA = 2 * hstepA, tstepB = 2 * hstepB;
    const unsigned ldsw = (unsigned)wid * 1024u;
    const int aoff = lds_byte(wr * 64 + fr, fq * 8), boff = lds_byte(wc * 32 + fr, fq * 8);
#define PG8_SA(b, h) (((b) * 2 + (h)) * HTB)
#define PG8_SB(b, h) ((4 + (b) * 2 + (h)) * HTB)
#define PG8_STAGE(bufoff, gbase, voff) do { _Pragma("unroll") for (int _i = 0; _i < 2; ++_i) \
        __builtin_amdgcn_global_load_lds((const unsigned*)((const char*)(gbase) + (voff)[_i]), (LAS unsigned*)(lds + (bufoff) + ldsw + _i * 8192), 16, 0, 0); } while (0)
#define PG8_LDA(dst, b, h) do { _Pragma("unroll") for (int m = 0; m < 4; ++m) _Pragma("unroll") for (int k = 0; k < 2; ++k) dst[m][k] = *(const LAS bf16x8*)(lds + PG8_SA(b, h) + aoff + m * 2048 + k * 1024); } while (0)
#define PG8_LDB(dst, b, h) do { _Pragma("unroll") for (int n = 0; n < 2; ++n) _Pragma("unroll") for (int k = 0; k < 2; ++k) dst[n][k] = *(const LAS bf16x8*)(lds + PG8_SB(b, h) + boff + n * 2048 + k * 1024); } while (0)
#define PG8_MMA(ai, bj, At, Bt) do { __builtin_amdgcn_s_setprio(1); _Pragma("unroll") for (int m = 0; m < 4; ++m) _Pragma("unroll") for (int n = 0; n < 2; ++n) _Pragma("unroll") for (int k = 0; k < 2; ++k) \
        acc[ai][bj][m][n] = __builtin_amdgcn_mfma_f32_16x16x32_bf16(Bt[n][k], At[m][k], acc[ai][bj][m][n], 0, 0, 0); __builtin_amdgcn_s_setprio(0); } while (0)
#define PG8_WAIT_V(n) asm volatile("s_waitcnt vmcnt(" #n ")" ::: "memory")
#define PG8_WAIT_L(n) asm volatile("s_waitcnt lgkmcnt(" #n ")" ::: "memory")
#define PG8_BAR __builtin_amdgcn_s_barrier()
#define PG8_SCHED __builtin_amdgcn_sched_barrier(0)
    Unit cur, nxt; int ui = 0;
    if (!S.next(0, cur)) return;

    f32x4 acc[2][2][4][2];
#pragma unroll
    for (int a = 0; a < 2; ++a)
#pragma unroll
        for (int b = 0; b < 2; ++b)
#pragma unroll
            for (int m = 0; m < 4; ++m)
#pragma unroll
                for (int n = 0; n < 2; ++n) acc[a][b][m][n] = (f32x4){0.f, 0.f, 0.f, 0.f};
    bf16x8 At[4][2], B0[2][2], B1[2][2];
    const char* cA = (const char*)g.A + (size_t)cur.pm * tstepA; const char* cB = (const char*)g.Bt + (size_t)cur.pn * tstepB;
    PG8_STAGE(PG8_SB(0, 0), cB, voffB); PG8_STAGE(PG8_SA(0, 0), cA, voffA); PG8_STAGE(PG8_SB(0, 1), cB + hstepB, voffB); PG8_STAGE(PG8_SA(0, 1), cA + hstepA, voffA);
    if constexpr (Epi::NEEDS_RSTD) {
        LAS float* rt = (LAS float*)(lds + STAGE_BYTES);
        for (int i = tid >> 8; i < 4; i += 2) { Unit uu; if (!S.next(i, uu)) break; rt[i * 256 + (tid & 255)] = row_rstd(E.ssq, uu.pm * BM + (tid & 255)); }
        __syncthreads();
    }
    if (wr == 1) PG8_BAR;
    PG8_WAIT_V(4); PG8_BAR;
    PG8_STAGE(PG8_SB(1, 0), cB + kstep, voffB); PG8_STAGE(PG8_SA(1, 0), cA + kstep, voffA); PG8_STAGE(PG8_SB(1, 1), cB + hstepB + kstep, voffB);
    PG8_WAIT_V(6); PG8_BAR;
    for (;;) {
        const bool has_next = S.next(ui + 1, nxt);
        const char* nA = has_next ? (const char*)g.A + (size_t)nxt.pm * tstepA : cA; const char* nB = has_next ? (const char*)g.Bt + (size_t)nxt.pn * tstepB : cB;
        for (int t = 0; t < nt; t += 2) {
            const bool last = (t == nt - 2);
            const char* a1 = cA + (size_t)(t + 1) * kstep;
            const char* a2 = last ? nA : cA + (size_t)(t + 2) * kstep; const char* b2 = last ? nB : cB + (size_t)(t + 2) * kstep;
            const char* a3 = a2 + kstep; const char* b3 = b2 + kstep;
            PG8_LDB(B0, 0, 0); PG8_SCHED; PG8_LDA(At, 0, 0); PG8_STAGE(PG8_SA(1, 1), a1 + hstepA, voffA);
            PG8_WAIT_L(8); PG8_BAR; PG8_WAIT_L(0); PG8_MMA(0, 0, At, B0); PG8_BAR; PG8_SCHED;
            PG8_LDB(B1, 0, 1); PG8_STAGE(PG8_SB(0, 0), b2, voffB);
            PG8_BAR; PG8_WAIT_L(0); PG8_MMA(0, 1, At, B1); PG8_BAR;
            PG8_LDA(At, 0, 1); PG8_STAGE(PG8_SA(0, 0), a2, voffA);
            PG8_BAR; PG8_WAIT_L(0); PG8_MMA(1, 0, At, B0); PG8_BAR; PG8_SCHED;
            PG8_STAGE(PG8_SB(0, 1), b2 + hstepB, voffB);
            PG8_WAIT_V(6); PG8_BAR; PG8_MMA(1, 1, At, B1); PG8_BAR;
            PG8_LDB(B0, 1, 0); PG8_SCHED; PG8_LDA(At, 1, 0); PG8_STAGE(PG8_SA(0, 1), a2 + hstepA, voffA);
            PG8_WAIT_L(8); PG8_BAR; PG8_WAIT_L(0); PG8_MMA(0, 0, At, B0); PG8_BAR; PG8_SCHED;
            PG8_LDB(B1, 1, 1); PG8_STAGE(PG8_SB(1, 0), b3, voffB);
            PG8_BAR; PG8_WAIT_L(0); PG8_MMA(0, 1, At, B1); PG8_BAR;
            PG8_LDA(At, 1, 1); PG8_STAGE(PG8_SA(1, 0), a3, voffA);
            PG8_BAR; PG8_WAIT_L(0); PG8_MMA(1, 0, At, B0); PG8_BAR; PG8_SCHED;
            PG8_STAGE(PG8_SB(1, 1), b3 + hstepB, voffB);
            PG8_WAIT_V(6); PG8_BAR; PG8_MMA(1, 1, At, B1); PG8_BAR;
        }
        E(acc, cur, ui, (const LAS float*)(lds + STAGE_BYTES), wr, wc, fr, fq);
        if (!has_next) break;
#pragma unroll
        for (int a = 0; a < 2; ++a)
#pragma unroll
            for (int b = 0; b < 2; ++b)
#pragma unroll
                for (int m = 0; m < 4; ++m)
#pragma unroll
                    for (int n = 0; n < 2; ++n) acc[a][b][m][n] = (f32x4){0.f, 0.f, 0.f, 0.f};
        cur = nxt; cA = nA; cB = nB; ++ui;
    }
    PG8_WAIT_V(0);
    if (wr == 0) PG8_BAR;
    PG8_BAR;
#undef PG8_SA
#undef PG8_SB
#undef PG8_STAGE
#undef PG8_LDA
#undef PG8_LDB
#undef PG8_MMA
#undef PG8_WAIT_V
#undef PG8_WAIT_L
#undef PG8_BAR
#undef PG8_SCHED
}

constexpr int KSTR = 272, VSTR = 288, AROWS = 272;
constexpr int LDSA_K = 0, LDSA_V = AROWS * KSTR, LDS_TAB = LDSA_V + AROWS * VSTR;
constexpr int LDSC_V = 0, LDSC_K = 192 * VSTR;
constexpr int LDS_BYTES = LDS_TAB + 2048;

constexpr float LOG2E = 1.4426950408889634f, LN2 = 0.6931471805599453f, DEFER_THR = 11.0f;
typedef short v4i16_t __attribute__((ext_vector_type(4)));
__device__ __forceinline__ s16x4 tr_read(LAS const unsigned char* p) { return __builtin_bit_cast(s16x4, __builtin_amdgcn_ds_read_tr16_b64_v4i16((LAS v4i16_t*)p)); }

__device__ __forceinline__ void store_o_rows(bf16_t* rowp, const f32x4 (&O)[8], float inv, int g) {
    bf16_t* p = rowp + 4 * (g & ~1) + 16 * (g & 1);
#pragma unroll
    for (int k = 0; k < 4; ++k) {
        const f32x4 e = O[2 * k] * inv, o = O[2 * k + 1] * inv;
        const unsigned e0 = cvt_pk_bf16(e[0], e[1]), e1 = cvt_pk_bf16(e[2], e[3]), o0 = cvt_pk_bf16(o[0], o[1]), o1 = cvt_pk_bf16(o[2], o[3]);
        auto r0 = __builtin_amdgcn_permlane16_swap(e0, o0, false, false);
        auto r1 = __builtin_amdgcn_permlane16_swap(e1, o1, false, false);
        u32x4 w; w.x = r0[0]; w.y = r1[0]; w.z = r0[1]; w.w = r1[1];
        *(u32x4*)(p + 32 * k) = w;
    }
}
template <int LDS_K>
__device__ __forceinline__ void attn_qk(LAS const unsigned char* lds, int rowa, int rowb, const bf16x8 (&qf)[4], int lane, f32x4& sa, f32x4& sb) {
    const int fr = lane & 15, g = lane >> 4;
    sa = (f32x4){0.f, 0.f, 0.f, 0.f}; sb = sa;
    LAS const unsigned char* pa = lds + LDS_K + (rowa + fr) * KSTR + g * 16;
    LAS const unsigned char* pb = lds + LDS_K + (rowb + fr) * KSTR + g * 16;
#pragma unroll
    for (int s = 0; s < 4; ++s) {
        const bf16x8 ka = *(const LAS bf16x8*)(pa + s * 64), kb = *(const LAS bf16x8*)(pb + s * 64);
        sa = __builtin_amdgcn_mfma_f32_16x16x32_bf16(ka, qf[s], sa, 0, 0, 0);
        sb = __builtin_amdgcn_mfma_f32_16x16x32_bf16(kb, qf[s], sb, 0, 0, 0);
    }
}
template <int LDS_V>
__device__ __forceinline__ void attn_pv(LAS const unsigned char* lds, int rowa, int rowb, const f32x4 sa, const f32x4 sb, f32x4 (&O)[8], float& m_run, float& l_run, int lane) {
    const int g = lane >> 4, ii = lane & 15;
    float mx = fmaxf(fmaxf(fmaxf(sa[0], sa[1]), fmaxf(sa[2], sa[3])), fmaxf(fmaxf(sb[0], sb[1]), fmaxf(sb[2], sb[3])));
    if (__builtin_amdgcn_ballot_w64(mx > m_run + DEFER_THR) != 0ull) {
        mx = fmaxf(mx, __shfl_xor(mx, 16)); mx = fmaxf(mx, __shfl_xor(mx, 32));
        const float m_new = fmaxf(m_run, mx);
        const float alpha = __builtin_amdgcn_exp2f(m_run - m_new);
        l_run *= alpha; m_run = m_new;
#pragma unroll
        for (int cb = 0; cb < 8; ++cb) O[cb] *= alpha;
    }
    float pa[4], pb[4]; float sum = 0.f;
#pragma unroll
    for (int j = 0; j < 4; ++j) { pa[j] = __builtin_amdgcn_exp2f(sa[j] - m_run); pb[j] = __builtin_amdgcn_exp2f(sb[j] - m_run); sum += pa[j] + pb[j]; }
    l_run += sum;
    u32x4 pw; pw.x = cvt_pk_bf16_t(pa[0], pa[1]); pw.y = cvt_pk_bf16_t(pa[2], pa[3]); pw.z = cvt_pk_bf16_t(pb[0], pb[1]); pw.w = cvt_pk_bf16_t(pb[2], pb[3]);
    const bf16x8 pf = __builtin_bit_cast(bf16x8, pw);
    LAS const unsigned char* va = lds + LDS_V + (rowa + 4 * g + (ii >> 2)) * VSTR + (ii & 3) * 8;
    LAS const unsigned char* vb = lds + LDS_V + (rowb + 4 * g + (ii >> 2)) * VSTR + (ii & 3) * 8;
#pragma unroll
    for (int cb = 0; cb < 8; ++cb) {
        const s16x4 lo = tr_read(va + cb * 32), hi = tr_read(vb + cb * 32);
        bf16x8 vf; vf[0] = lo[0]; vf[1] = lo[1]; vf[2] = lo[2]; vf[3] = lo[3]; vf[4] = hi[0]; vf[5] = hi[1]; vf[6] = hi[2]; vf[7] = hi[3];
        O[cb] = __builtin_amdgcn_mfma_f32_16x16x32_bf16(vf, pf, O[cb], 0, 0, 0);
    }
}

struct AItem { int bi, h, b, d, r, nb, L; };
__device__ __forceinline__ AItem a_decode(int item) { AItem a; a.bi = item & 63; a.h = (item >> 6) & 7; a.b = item >> 9; const int sh = 2 * a.b; a.d = 1 << sh; a.r = a.bi & (a.d - 1); a.nb = a.bi >> sh; a.L = SEQ >> sh; return a; }
__device__ __forceinline__ void a_load(int item, int tid, const bf16_t* Kb, const bf16_t* Vb, u32x4 (&kv)[8], u32x4 (&vv)[8]) {
    const AItem a = a_decode(item);
#pragma unroll
    for (int it = 0; it < 8; ++it) {
        const int cid = tid + NTHR * it, row = cid >> 4, ch = cid & 15; const int l = a.nb * 128 + row - 64;
        if (l >= 0 && l < a.L) { const size_t off = ((size_t)(l * a.d + a.r) * 1024 + a.h * 128 + ch * 8); kv[it] = *(const u32x4*)(Kb + off); vv[it] = *(const u32x4*)(Vb + off); }
        else { kv[it] = (u32x4){0u, 0u, 0u, 0u}; vv[it] = kv[it]; }
    }
}
__device__ __forceinline__ void a_store(LAS unsigned char* lds, int item, int tid, const float* t5, const u32x4 (&kv)[8], const u32x4 (&vv)[8]) {
    const AItem a = a_decode(item); LAS float* tab = (LAS float*)(lds + LDS_TAB);
#pragma unroll
    for (int it = 0; it < 8; ++it) { const int cid = tid + NTHR * it, row = cid >> 4, ch = cid & 15;
        *(LAS u32x4*)(lds + LDSA_K + row * KSTR + ch * 16) = kv[it]; *(LAS u32x4*)(lds + LDSA_V + row * VSTR + ch * 16) = vv[it]; }
    if (tid < 129) { const int rel = (tid - 64) * a.d; const int n = rel < 0 ? -rel : rel; int bk;
        if (n < 8) bk = n; else { int lg = 8 + (int)(logf((float)n / 8.0f) / 4.852030263919617f * 8.0f); bk = lg < 15 ? lg : 15; }
        if (rel > 0) bk += 16;
        tab[tid] = t5[bk * 8 + a.h] * LOG2E; }
}
__device__ __forceinline__ void a_compute(LAS unsigned char* lds, int item, int tid, const bf16x8 (&qf)[4], float* NUM, float* ML) {
    const int wid = __builtin_amdgcn_readfirstlane(tid >> 6), lane = tid & 63, fr = lane & 15, g = lane >> 4;
    const AItem a = a_decode(item); const int nb = a.nb, L = a.L, d = a.d, r = a.r, h = a.h, b = a.b;
    LAS float* tab = (LAS float*)(lds + LDS_TAB);
    const int i0 = 16 * wid, qi = i0 + fr; const int qpos = (nb * 128 + qi) * d + r;
    f32x4 O[8];
#pragma unroll
    for (int cb = 0; cb < 8; ++cb) O[cb] = (f32x4){0.f, 0.f, 0.f, 0.f};
    float m_run = -1e30f, l_run = 0.f;
    const float scale = 0.08838834764831845f * LOG2E;
    for (int pp = 0; pp < 5; ++pp) {
        const int rowa = i0 + 32 * pp, rowb = rowa + 16;
        f32x4 sa, sb; attn_qk<LDSA_K>(lds, rowa, rowb, qf, lane, sa, sb);
        {
            const int rela = rowa + 4 * g - qi, la = nb * 128 + rowa + 4 * g - 64; float ba[4], bb[4];
#pragma unroll
            for (int j = 0; j < 4; ++j) { int ta = rela + j; ta = ta < 0 ? 0 : (ta > 128 ? 128 : ta); int tb = rela + 16 + j; tb = tb < 0 ? 0 : (tb > 128 ? 128 : tb); ba[j] = tab[ta]; bb[j] = tab[tb]; }
#pragma unroll
            for (int j = 0; j < 4; ++j) {
                const int ra = rela + j, rb = rela + 16 + j, l0 = la + j, l1 = la + 16 + j;
                const bool oka = ((unsigned)ra <= 128u) && ((unsigned)l0 < (unsigned)L), okb = ((unsigned)rb <= 128u) && ((unsigned)l1 < (unsigned)L);
                const float va = fmaf(sa[j], scale, ba[j]), vb = fmaf(sb[j], scale, bb[j]);
                sa[j] = oka ? va : -INFINITY; sb[j] = okb ? vb : -INFINITY;
            }
        }
        attn_pv<LDSA_V>(lds, rowa, rowb, sa, sb, O, m_run, l_run, lane);
    }
    l_run += __shfl_xor(l_run, 16); l_run += __shfl_xor(l_run, 32);
    if (g == 0) { f32x2 ml; ml.x = m_run * LN2; ml.y = l_run; *(f32x2*)(ML + ((size_t)(b * 8 + h) * SEQ + qpos) * 2) = ml; }
    const float inv = 1.0f / l_run;
    store_o_rows((bf16_t*)NUM + ((size_t)b * SEQ + qpos) * 1024 + h * 128, O, inv, g);
}
__device__ __forceinline__ void attn_a_phase(LAS unsigned char* lds, int first, int stride, int count, const bf16_t* Qb, const bf16_t* Kb, const bf16_t* Vb, const float* t5, float* NUM, float* ML) {
    int tid = threadIdx.x; asm volatile("" : "+v"(tid));
    if (count <= 0) return;
    if (tid < 256) { const int row = 256 + (tid >> 4), ch = tid & 15; const u32x4 z = (u32x4){0u, 0u, 0u, 0u};
        *(LAS u32x4*)(lds + LDSA_K + row * KSTR + ch * 16) = z; *(LAS u32x4*)(lds + LDSA_V + row * VSTR + ch * 16) = z; }
    u32x4 kv[8], vv[8];
    a_load(first, tid, Kb, Vb, kv, vv);
    for (int k = 0; k < count; ++k) {
        const int item = first + k * stride;
        a_store(lds, item, tid, t5, kv, vv);
        __syncthreads();
        bf16x8 qf[4];
        { const AItem a = a_decode(item); const int wid = __builtin_amdgcn_readfirstlane(tid >> 6), lane = tid & 63; const int qpos = (a.nb * 128 + 16 * wid + (lane & 15)) * a.d + a.r;
#pragma unroll
          for (int s = 0; s < 4; ++s) qf[s] = *(const bf16x8*)(Qb + (size_t)qpos * 1024 + a.h * 128 + s * 32 + (lane >> 4) * 8); }
        if (k + 1 < count) a_load(item + stride, tid, Kb, Vb, kv, vv);
        a_compute(lds, item, tid, qf, NUM, ML);
        __syncthreads();
    }
}

__device__ __forceinline__ void attn_a_merge(const float* NUM, const float* ML, bf16_t* MG, int first, int stride, int lo, int hi) {
    const bf16_t* NB = (const bf16_t*)NUM;
    for (int it = lo + first; it < hi; it += stride) {
        const int token = it >> 7, c8 = (it & 127) * 8, h = c8 >> 7;
        const f32x2 a = *(const f32x2*)(ML + ((size_t)(0 * 8 + h) * SEQ + token) * 2), b = *(const f32x2*)(ML + ((size_t)(1 * 8 + h) * SEQ + token) * 2), c = *(const f32x2*)(ML + ((size_t)(2 * 8 + h) * SEQ + token) * 2);
        const float M = fmaxf(a.x, fmaxf(b.x, c.x)); float wa = __expf(a.x - M) * a.y, wb = __expf(b.x - M) * b.y, wc = __expf(c.x - M) * c.y;
        const float inv = 1.0f / (wa + wb + wc); wa *= inv; wb *= inv; wc *= inv;
        const u32x4 na = *(const u32x4*)(NB + ((size_t)0 * SEQ + token) * 1024 + c8), nb = *(const u32x4*)(NB + ((size_t)1 * SEQ + token) * 1024 + c8), nc = *(const u32x4*)(NB + ((size_t)2 * SEQ + token) * 1024 + c8);
        u32x4 w;
#pragma unroll
        for (int e = 0; e < 4; ++e) { const float lo_ = bf_lo(na[e]) * wa + bf_lo(nb[e]) * wb + bf_lo(nc[e]) * wc, hi_ = bf_hi(na[e]) * wa + bf_hi(nb[e]) * wb + bf_hi(nc[e]) * wc; w[e] = cvt_pk_bf16(lo_, hi_); }
        *(u32x4*)(MG + (size_t)token * DM + c8) = w;
    }
}

__device__ __forceinline__ int c_rs0(int item) { const int r0 = 2 * (item >> 4); return (r0 - 4) < 0 ? 0 : ((r0 - 4) > 120 ? 120 : (r0 - 4)); }
__device__ __forceinline__ void c_load(int item, int ci, int tid, const bf16_t* Kb, const bf16_t* Vb, u32x4 (&kv)[6], u32x4 (&vv)[6]) {
    const int h = item & 15, rs0 = c_rs0(item);
#pragma unroll
    for (int it = 0; it < 6; ++it) {
        const int cid = tid + NTHR * it, row = cid >> 4, ch = cid & 15; const int kr = rs0 + 3 * ci + (row >> 6), kc = row & 63;
        if (kr < 128) { const size_t off = ((size_t)(kr * 64 + kc) * DM + h * 128 + ch * 8); kv[it] = *(const u32x4*)(Kb + off); vv[it] = *(const u32x4*)(Vb + off); }
        else { kv[it] = (u32x4){0u, 0u, 0u, 0u}; vv[it] = kv[it]; }
    }
}
__device__ __forceinline__ void c_store(LAS unsigned char* lds, int tid, const u32x4 (&kv)[6], const u32x4 (&vv)[6]) {
#pragma unroll
    for (int it = 0; it < 6; ++it) { const int cid = tid + NTHR * it, row = cid >> 4, ch = cid & 15;
        *(LAS u32x4*)(lds + LDSC_K + row * KSTR + ch * 16) = kv[it]; *(LAS u32x4*)(lds + LDSC_V + row * VSTR + ch * 16) = vv[it]; }
}
__device__ __forceinline__ void attn_c_phase(LAS unsigned char* lds, int first, int stride, const bf16_t* Qb, const bf16_t* Kb, const bf16_t* Vb, const float* rpb, bf16_t* MG) {
    int tid = threadIdx.x; asm volatile("" : "+v"(tid));
    if (first >= 1024) return;
    const int wid = __builtin_amdgcn_readfirstlane(tid >> 6), lane = tid & 63, fr = lane & 15, g = lane >> 4;
    LAS float* tab = (LAS float*)(lds + LDS_TAB);
    const int rsel = wid >> 2, ct = wid & 3;
    const int colbase = (ct == 0) ? 0 : ((ct == 1) ? 8 : ((ct == 2) ? 24 : 32));
    const int qc = 16 * ct + fr; const int cws = (qc - 8) < 0 ? 0 : ((qc - 8) > 48 ? 48 : (qc - 8));
    const float scale = 0.08838834764831845f * LOG2E;
    u32x4 kv[6], vv[6];
    c_load(first, 0, tid, Kb, Vb, kv, vv);
    bf16x8 qf[4]; f32x4 O[8]; float m_run = -1e30f, l_run = 0.f;
    for (int item = first; item < 1024; item += stride) {
        const int h = item & 15, r0 = 2 * (item >> 4), rs0 = c_rs0(item);
        const int qr = r0 + rsel, token = qr * 64 + qc;
        const int rws = (qr - 4) < 0 ? 0 : ((qr - 4) > 120 ? 120 : (qr - 4));
#pragma unroll
        for (int s = 0; s < 4; ++s) qf[s] = *(const bf16x8*)(Qb + (size_t)token * DM + h * 128 + s * 32 + g * 8);
#pragma unroll
        for (int cb = 0; cb < 8; ++cb) O[cb] = (f32x4){0.f, 0.f, 0.f, 0.f};
        m_run = -1e30f; l_run = 0.f;
        for (int ci = 0; ci < 3; ++ci) {
            c_store(lds, tid, kv, vv);
            if (ci == 0 && tid < 465) tab[tid] = rpb[h * 465 + tid] * LOG2E;
            __syncthreads();
            if (ci < 2) c_load(item, ci + 1, tid, Kb, Vb, kv, vv);
            else if (item + stride < 1024) c_load(item + stride, 0, tid, Kb, Vb, kv, vv);
            for (int lr = 0; lr < 3; ++lr) {
                const int kr = rs0 + 3 * ci + lr;
                if (kr < rws || kr >= rws + 8) continue;
                const int rowa = lr * 64 + colbase, rowb = rowa + 16;
                f32x4 sa, sb; attn_qk<LDSC_K>(lds, rowa, rowb, qf, lane, sa, sb);
                const int tb = (kr - qr + 7) * 31 + 15 - qc; const int kc0 = colbase + 4 * g; float ba[4], bb[4];
#pragma unroll
                for (int j = 0; j < 4; ++j) { int ta = tb + kc0 + j; ta = ta < 0 ? 0 : (ta > 464 ? 464 : ta); int t2 = tb + kc0 + 16 + j; t2 = t2 < 0 ? 0 : (t2 > 464 ? 464 : t2); ba[j] = tab[ta]; bb[j] = tab[t2]; }
#pragma unroll
                for (int j = 0; j < 4; ++j) {
                    const bool oka = (unsigned)(kc0 + j - cws) < 16u, okb = (unsigned)(kc0 + 16 + j - cws) < 16u;
                    const float va = fmaf(sa[j], scale, ba[j]), vb = fmaf(sb[j], scale, bb[j]);
                    sa[j] = oka ? va : -INFINITY; sb[j] = okb ? vb : -INFINITY;
                }
                attn_pv<LDSC_V>(lds, rowa, rowb, sa, sb, O, m_run, l_run, lane);
            }
            __syncthreads();
        }
        l_run += __shfl_xor(l_run, 16); l_run += __shfl_xor(l_run, 32);
        const float inv = 1.0f / l_run;
        store_o_rows(MG + (size_t)token * DM + h * 128, O, inv, g);
    }
}

__device__ __forceinline__ void s5_gen(LAS unsigned char* lds, const Params& P, int j, int g) {
    const int tid = threadIdx.x;
    LAS f32x2* pw = (LAS f32x2*)lds;
    LAS f32x2* bb = (LAS f32x2*)(lds + 33792);
    LAS f32x2* cc = (LAS f32x2*)(lds + 33792 + 16384);
    LAS float* kern = (LAS float*)(lds + 33792 + 32768);
    const float* lam_re = P.in[4]; const float* lam_im = P.in[5]; const float* log_step = P.in[6];
    const float* b_re = P.in[7]; const float* b_im = P.in[8]; const float* c_re = P.in[9]; const float* c_im = P.in[10]; const float* dsk = P.in[11];
    for (int e = tid; e < 2 * 33 * 64; e += NTHR) {
        const int pp = e & 63, k = (e >> 6) % 33, dir = e / (33 * 64);
        const int idx = ((j * 2 + dir) * 64 + g) * 64 + pp;
        const float step = expf(log_step[(j * 2 + dir) * 64 + g]); const float lr = fminf(lam_re[idx], -1e-4f), li = lam_im[idx];
        const float rho = lr * step, th = li * step; const float mg = expf((float)k * rho); float sn, cs; sincosf((float)k * th, &sn, &cs);
        f32x2 v; v.x = mg * cs; v.y = mg * sn; pw[e] = v;
    }
    if (tid < 128) {
        const int dir = tid >> 6, pp = tid & 63; const int idx = ((j * 2 + dir) * 64 + g) * 64 + pp;
        const double step = exp((double)log_step[(j * 2 + dir) * 64 + g]); const double lr = fmin((double)lam_re[idx], -1e-4), li = (double)lam_im[idx];
        const double mg = exp(lr * step); const double abr = mg * cos(li * step), abi = mg * sin(li * step); const double den = lr * lr + li * li;
        const float zr = (float)(((abr - 1.0) * lr + abi * li) / den), zi = (float)((abi * lr - (abr - 1.0) * li) / den);
        for (int c = 0; c < 16; ++c) { const float br = b_re[((j * 64 + g) * 64 + pp) * 16 + c], bi = b_im[((j * 64 + g) * 64 + pp) * 16 + c];
            f32x2 v; v.x = zr * br - zi * bi; v.y = zr * bi + zi * br; bb[(dir * 64 + pp) * 16 + c] = v; }
        const double mg32 = exp(32.0 * lr * step); f32x2 a32; a32.x = (float)(mg32 * cos(32.0 * li * step)); a32.y = (float)(mg32 * sin(32.0 * li * step));
        *(f32x2*)(P.ws + WS_A32 + (size_t)idx * 8) = a32;
    }
    for (int e = tid; e < 2 * 16 * 64; e += NTHR) { const int dir = e >> 10, rem = e & 1023; const size_t gi = (size_t)((j * 2 + dir) * 64 + g) * 1024 + rem; f32x2 v; v.x = c_re[gi]; v.y = c_im[gi]; cc[e] = v; }
    __syncthreads();
    for (int e = tid; e < 1024; e += NTHR) {
        const int dir = e >> 9, tau = (e >> 4) & 31, co = e & 15; float acc16[16];
#pragma unroll
        for (int ci = 0; ci < 16; ++ci) acc16[ci] = 0.f;
        for (int pp = 0; pp < 64; ++pp) {
            const f32x2 w = pw[(dir * 33 + tau) * 64 + pp], c = cc[(dir * 16 + co) * 64 + pp];
            const float tr = c.x * w.x - c.y * w.y, ti = c.x * w.y + c.y * w.x;
            const LAS f32x4* bp = (const LAS f32x4*)(bb + (dir * 64 + pp) * 16);
#pragma unroll
            for (int q = 0; q < 8; ++q) { const f32x4 b2 = bp[q]; acc16[2 * q] += tr * b2[0] - ti * b2[1]; acc16[2 * q + 1] += tr * b2[2] - ti * b2[3]; }
        }
#pragma unroll
        for (int q = 0; q < 4; ++q) { f32x4 o; o[0] = acc16[4 * q]; o[1] = acc16[4 * q + 1]; o[2] = acc16[4 * q + 2]; o[3] = acc16[4 * q + 3]; *(LAS f32x4*)(kern + e * 16 + 4 * q) = o; }
    }
    __syncthreads();
    bf16_t* B3 = (bf16_t*)(P.ws + WS_B3 + (size_t)j * SZ_B3) + (size_t)g * 512 * 768;
    for (int ch = tid; ch < 512 * 96; ch += NTHR) {
        const int row = ch / 96, kc = (ch % 96) * 8, t = row >> 4, co = row & 15; float v[8];
        if (kc < 512) { const int s = kc >> 4, ci0 = kc & 15; f32x4 a0 = (f32x4){0.f, 0.f, 0.f, 0.f}, a1 = a0;
            if (s <= t) { const LAS f32x4* kp = (const LAS f32x4*)(kern + ((0 * 32 + (t - s)) * 16 + co) * 16 + ci0); a0 += kp[0]; a1 += kp[1]; }
            if (s >= t) { const LAS f32x4* kp = (const LAS f32x4*)(kern + ((1 * 32 + (s - t)) * 16 + co) * 16 + ci0); a0 += kp[0]; a1 += kp[1]; }
#pragma unroll
            for (int e = 0; e < 4; ++e) { v[e] = a0[e]; v[4 + e] = a1[e]; }
            if (s == t && (co >> 3) == (ci0 >> 3)) {
#pragma unroll
                for (int e = 0; e < 8; ++e) if (e == (co & 7)) v[e] += dsk[j * 1024 + 16 * g + co];
            } }
        else { const int kk = kc - 512, dir = kk >> 7, im = (kk >> 6) & 1, p0 = kk & 63; const int ex = (dir == 0) ? (t + 1) : (32 - t);
#pragma unroll
            for (int e = 0; e < 8; ++e) { const int pp = p0 + e; const f32x2 c = cc[(dir * 16 + co) * 64 + pp], w = pw[(dir * 33 + ex) * 64 + pp];
                v[e] = im ? -(c.x * w.y + c.y * w.x) : (c.x * w.x - c.y * w.y); } }
        u32x4 w; w.x = cvt_pk_bf16(v[0], v[1]); w.y = cvt_pk_bf16(v[2], v[3]); w.z = cvt_pk_bf16(v[4], v[5]); w.w = cvt_pk_bf16(v[6], v[7]);
        *(u32x4*)(B3 + (size_t)row * 768 + kc) = w;
    }
    bf16_t* B1 = (bf16_t*)(P.ws + WS_B1 + (size_t)j * SZ_B1) + (size_t)g * 256 * 512;
    for (int ch = tid; ch < 256 * 64; ch += NTHR) {
        const int row = ch >> 6, kc = (ch & 63) * 8, dir = row >> 7, im = (row >> 6) & 1, pp = row & 63, t = kc >> 4, c0 = kc & 15; const int ex = (dir == 0) ? (31 - t) : t;
        const f32x2 w = pw[(dir * 33 + ex) * 64 + pp]; float v[8];
#pragma unroll
        for (int e = 0; e < 8; ++e) { const f32x2 b = bb[(dir * 64 + pp) * 16 + c0 + e]; v[e] = im ? (w.x * b.y + w.y * b.x) : (w.x * b.x - w.y * b.y); }
        u32x4 wv; wv.x = cvt_pk_bf16(v[0], v[1]); wv.y = cvt_pk_bf16(v[2], v[3]); wv.z = cvt_pk_bf16(v[4], v[5]); wv.w = cvt_pk_bf16(v[6], v[7]);
        *(u32x4*)(B1 + (size_t)row * 512 + kc) = wv;
    }
    __syncthreads();
}

__device__ __forceinline__ void s5_carry(LAS unsigned char* lds, const Params& P, int j, int g, int dir) {
    int tid = threadIdx.x; asm volatile("" : "+v"(tid));
    const float* Z = (const float*)(P.ws + WS_Z); bf16_t* U2 = (bf16_t*)(P.ws + WS_U2);
    LAS float* zl = (LAS float*)lds;
#pragma unroll
    for (int it = 0; it < 16; ++it) { const int cid = tid + NTHR * it, n = cid >> 5, c4 = (cid & 31) * 4;
        *(LAS f32x4*)(zl + n * 128 + c4) = *(const f32x4*)(Z + (size_t)(g * 256 + n) * 256 + dir * 128 + c4); }
    __syncthreads();
    if (tid < 64) {
        const int pp = tid; const int idx = ((j * 2 + dir) * 64 + g) * 64 + pp;
        const f32x2 a32 = *(const f32x2*)(P.ws + WS_A32 + (size_t)idx * 8); const float ar = a32.x, ai = a32.y;
        float cr = 0.f, cim = 0.f;
        bf16_t* up = U2 + (size_t)g * 256 * 768 + 512 + dir * 128 + pp;
        for (int s = 0; s < 256; ++s) {
            const int n = dir ? (255 - s) : s;
            up[(size_t)n * 768] = (bf16_t)(cvt_pk_bf16(cr, 0.f) & 0xffffu); up[(size_t)n * 768 + 64] = (bf16_t)(cvt_pk_bf16(cim, 0.f) & 0xffffu);
            const float zr = zl[n * 128 + pp], zi = zl[n * 128 + 64 + pp];
            const float nr = ar * cr - ai * cim + zr, ni = ar * cim + ai * cr + zi; cr = nr; cim = ni;
        }
    }
    __syncthreads();
}

__device__ __forceinline__ void s5_carry2(const Params& P, int j, int g) {
    int tid = threadIdx.x; asm volatile("" : "+v"(tid));
    const int wid = __builtin_amdgcn_readfirstlane(tid >> 6), pp = tid & 63;
    if (wid < 2) {
        const int dir = wid; const int idx = ((j * 2 + dir) * 64 + g) * 64 + pp;
        const f32x2 a32 = *(const f32x2*)(P.ws + WS_A32 + (size_t)idx * 8); const float ar = a32.x, ai = a32.y;
        const float* zp = (const float*)(P.ws + WS_Z) + (size_t)(g * 256) * 256 + dir * 128 + pp;
        bf16_t* up = (bf16_t*)(P.ws + WS_U2) + (size_t)g * 256 * 768 + 512 + dir * 128 + pp;
        float cr = 0.f, cim = 0.f; float zr[8], zi[8], nzr[8], nzi[8];
#pragma unroll
        for (int u = 0; u < 8; ++u) { const int n = dir ? (255 - u) : u; zr[u] = zp[(size_t)n * 256]; zi[u] = zp[(size_t)n * 256 + 64]; }
        for (int s0 = 0; s0 < 256; s0 += 8) {
            if (s0 + 8 < 256) {
#pragma unroll
                for (int u = 0; u < 8; ++u) { const int n = dir ? (255 - (s0 + 8 + u)) : (s0 + 8 + u); nzr[u] = zp[(size_t)n * 256]; nzi[u] = zp[(size_t)n * 256 + 64]; }
            }
#pragma unroll
            for (int u = 0; u < 8; ++u) { const int n = dir ? (255 - (s0 + u)) : (s0 + u);
                up[(size_t)n * 768] = (bf16_t)(cvt_pk_bf16(cr, 0.f) & 0xffffu); up[(size_t)n * 768 + 64] = (bf16_t)(cvt_pk_bf16(cim, 0.f) & 0xffffu);
                const float nr = ar * cr - ai * cim + zr[u], ni = ar * cim + ai * cr + zi[u]; cr = nr; cim = ni; }
#pragma unroll
            for (int u = 0; u < 8; ++u) { zr[u] = nzr[u]; zi[u] = nzi[u]; }
        }
    }
    __syncthreads();
}

__device__ __forceinline__ void conv_tile(const float* src, bf16_t* dst, int K, int N, int tile, int lane, const float* gk) {
    const int tn = N >> 5; const int k0 = (tile / tn) * 64, n0 = (tile % tn) * 32; const int kg = lane & 7, jn = lane >> 3;
    f32x4 v[8]; const float* sp = src + (size_t)(k0 + 8 * kg) * N + n0 + 4 * jn;
#pragma unroll
    for (int r = 0; r < 8; ++r) v[r] = *(const f32x4*)(sp + (size_t)r * N);
    if (gk) { const f32x4 g0 = *(const f32x4*)(gk + k0 + 8 * kg), g1 = *(const f32x4*)(gk + k0 + 8 * kg + 4);
#pragma unroll
        for (int r = 0; r < 4; ++r) { v[r] *= g0[r]; v[4 + r] *= g1[r]; } }
#pragma unroll
    for (int i = 0; i < 4; ++i) { u32x4 w; w.x = cvt_pk_bf16(v[0][i], v[1][i]); w.y = cvt_pk_bf16(v[2][i], v[3][i]); w.z = cvt_pk_bf16(v[4][i], v[5][i]); w.w = cvt_pk_bf16(v[6][i], v[7][i]);
        *(u32x4*)(dst + (size_t)(n0 + 4 * jn + i) * K + k0 + 8 * kg) = w; }
}
constexpr int T_WIN = 4096, T_WOUT = 2048, T_GLU = 512, T_QKV = 6144, T_W1 = 8192, T_W2 = 8192;
constexpr int T_EVEN = T_WIN + T_WOUT + T_GLU + T_W1 + T_W2, T_ODD = T_QKV + T_WOUT + T_W1 + T_W2, T_PAIR = T_EVEN + T_ODD, T_ALL = 2 * T_PAIR;
__device__ __forceinline__ void conv_dispatch(const Params& P, int tile, int lane) {
    const int j = tile / T_PAIR; int rem = tile % T_PAIR; unsigned char* ws = P.ws;
    if (rem < T_EVEN) { const int i = 2 * j;
        if (rem < T_WIN) { conv_tile(P.in[2] + (size_t)j * 2048 * 4096, (bf16_t*)(ws + WS_WIN + j * SZ_WIN), 2048, 4096, rem, lane, P.in[16] + (size_t)i * DM); return; } rem -= T_WIN;
        if (rem < T_WOUT) { conv_tile(P.in[3] + (size_t)j * 2048 * 2048, (bf16_t*)(ws + WS_WOUT + j * SZ_WOUT), 2048, 2048, rem, lane, nullptr); return; } rem -= T_WOUT;
        if (rem < T_GLU) { conv_tile(P.in[12] + (size_t)j * 1024 * 1024, (bf16_t*)(ws + WS_GLU + j * SZ_GLU), 1024, 1024, rem, lane, nullptr); return; } rem -= T_GLU;
        if (rem < T_W1) { conv_tile(P.in[18] + (size_t)i * 2048 * 8192, (bf16_t*)(ws + WS_W1 + i * SZ_W1), 2048, 8192, rem, lane, P.in[17] + (size_t)i * DM); return; } rem -= T_W1;
        conv_tile(P.in[19] + (size_t)i * 8192 * 2048, (bf16_t*)(ws + WS_W2 + i * SZ_W2), 8192, 2048, rem, lane, nullptr);
    } else { rem -= T_EVEN; const int i = 2 * j + 1;
        if (rem < T_QKV) { conv_tile(P.in[13] + (size_t)j * 2048 * 6144, (bf16_t*)(ws + WS_QKV + j * SZ_QKV), 2048, 6144, rem, lane, P.in[16] + (size_t)i * DM); return; } rem -= T_QKV;
        if (rem < T_WOUT) { conv_tile(P.in[14] + (size_t)j * 2048 * 2048, (bf16_t*)(ws + WS_COUT + j * SZ_WOUT), 2048, 2048, rem, lane, nullptr); return; } rem -= T_WOUT;
        if (rem < T_W1) { conv_tile(P.in[18] + (size_t)i * 2048 * 8192, (bf16_t*)(ws + WS_W1 + i * SZ_W1), 2048, 8192, rem, lane, P.in[17] + (size_t)i * DM); return; } rem -= T_W1;
        conv_tile(P.in[19] + (size_t)i * 8192 * 2048, (bf16_t*)(ws + WS_W2 + i * SZ_W2), 8192, 2048, rem, lane, nullptr);
    }
}

#define XB_TMO      128
#define XB_XCNT(j)  (256  + 64 * (j))
#define XB_XSUB(j)  (1280 + 64 * (j))
#define XB_XGEN(j)  (2304 + 64 * (j))
#define XB_TOP      3328
#define XB_TOPGEN   3392
#define XCD_BAR_WORDS 3456
#define XB_SPIN_CAP (1u << 18)
__device__ __forceinline__ unsigned xb_ld(unsigned* p)              { return __hip_atomic_load(p, __ATOMIC_RELAXED, __HIP_MEMORY_SCOPE_AGENT); }
__device__ __forceinline__ unsigned xb_add(unsigned* p, unsigned v) { return __hip_atomic_fetch_add(p, v, __ATOMIC_RELAXED, __HIP_MEMORY_SCOPE_AGENT); }
__device__ __forceinline__ unsigned xb_xcc_id() { return (unsigned)__builtin_amdgcn_s_getreg((3 << 11) | 20) & 0xFu; }
#define XB_SPIN(cond, bar) do { unsigned _sp = 0; while (cond) { __builtin_amdgcn_s_sleep(1); \
    if ((++_sp & 255u) == 0u) { if (xb_ld(&(bar)[XB_TMO])) break; if (_sp > XB_SPIN_CAP) { atomicAdd(&(bar)[XB_TMO], 1u); break; } } } } while (0)
struct XcdBarrier { unsigned* bar; unsigned x; volatile LAS unsigned* st; };
__device__ __forceinline__ XcdBarrier xcd_barrier_post(unsigned* bar, volatile LAS unsigned* st) {
    XcdBarrier b; b.bar = bar; b.x = xb_xcc_id(); b.st = st;
    if (threadIdx.x == 0) (void)xb_add(&bar[XB_XCNT(b.x)], 1u);
    return b;
}
__device__ __forceinline__ void xcd_barrier_complete(unsigned* bar, unsigned x, unsigned& nloc, unsigned& nx) {
    const unsigned G = gridDim.x * gridDim.y * gridDim.z;
    unsigned sum, cnt, mine, sp = 0u;
    for (;;) {
        sum = 0u; cnt = 0u; mine = 0u;
#pragma unroll
        for (unsigned j = 0; j < 16; ++j) { const unsigned c = xb_ld(&bar[XB_XCNT(j)]); sum += c; cnt += (c > 0u) ? 1u : 0u; mine = (j == x) ? c : mine; }
        if (sum == G) break;
        __builtin_amdgcn_s_sleep(1);
        if ((++sp & 255u) == 0u) { if (xb_ld(&bar[XB_TMO])) break; if (sp > XB_SPIN_CAP) { atomicAdd(&bar[XB_TMO], 1u); break; } }
    }
    nloc = mine > 0u ? mine : 1u; nx = cnt > 0u ? cnt : 1u;
}
__device__ __forceinline__ void xcd_barrier(const XcdBarrier& b) {
    asm volatile("s_waitcnt vmcnt(0)" ::: "memory");
    __syncthreads();
    if (threadIdx.x == 0) {
        unsigned* bar = b.bar;
        __builtin_amdgcn_s_waitcnt(0);
        unsigned nloc = b.st[0], nx = b.st[1];
        if (nloc == 0u) { xcd_barrier_complete(bar, b.x, nloc, nx); b.st[0] = nloc; b.st[1] = nx; }
        const unsigned old = xb_add(&bar[XB_XSUB(b.x)], 1u);
        const unsigned gen = old / nloc;
        if (old + 1u == (gen + 1u) * nloc) {
            __builtin_amdgcn_fence(__ATOMIC_RELEASE, "agent");
            asm volatile("s_waitcnt vmcnt(0)" ::: "memory");
            const unsigned og = xb_add(&bar[XB_TOP], 1u);
            const unsigned tg = og / nx;
            if (og + 1u == (tg + 1u) * nx) xb_add(&bar[XB_TOPGEN], 1u);
            else XB_SPIN(xb_ld(&bar[XB_TOPGEN]) == tg, bar);
            __builtin_amdgcn_fence(__ATOMIC_ACQUIRE, "agent");
            xb_add(&bar[XB_XGEN(b.x)], 1u);
            asm volatile("s_waitcnt vmcnt(0)" ::: "memory");
        } else {
            XB_SPIN(xb_ld(&bar[XB_XGEN(b.x)]) == gen, bar);
            __builtin_amdgcn_fence(__ATOMIC_ACQUIRE, "agent");
            asm volatile("s_waitcnt vmcnt(0)" ::: "memory");
        }
    }
    __syncthreads();
}
#define GB_WORD(gid) (XCD_BAR_WORDS + 16 * (gid))
__device__ __forceinline__ void group_barrier(unsigned* bar, int gid) {
    asm volatile("s_waitcnt vmcnt(0)" ::: "memory");
    __syncthreads();
    if (threadIdx.x == 0) {
        __builtin_amdgcn_fence(__ATOMIC_RELEASE, "agent");
        asm volatile("s_waitcnt vmcnt(0)" ::: "memory");
        const unsigned old = xb_add(&bar[GB_WORD(gid)], 1u);
        const unsigned target = (old / 8u + 1u) * 8u;
        XB_SPIN(xb_ld(&bar[GB_WORD(gid)]) < target, bar);
        __builtin_amdgcn_fence(__ATOMIC_ACQUIRE, "agent");
        asm volatile("s_waitcnt vmcnt(0)" ::: "memory");
    }
    __syncthreads();
}
constexpr int MERGE_ITEMS = SEQ * 128, MERGE_SPLIT = (MERGE_ITEMS / 16) * 7;
constexpr int LDS_XB = LDS_BYTES - 16;

__global__ void __launch_bounds__(NTHR) hybrid_encoder_fwd(Params P) {
    extern __shared__ __attribute__((aligned(16))) unsigned char lds_raw[];
    LAS unsigned char* lds = (LAS unsigned char*)lds_raw;
    cg::grid_group grid = cg::this_grid();
    if (threadIdx.x == 0) { *(volatile LAS unsigned*)(lds + LDS_XB) = 0u; *(volatile LAS unsigned*)(lds + LDS_XB + 4) = 0u; }
    __syncthreads();
    const XcdBarrier xb = xcd_barrier_post((unsigned*)P.ws, (volatile LAS unsigned*)(lds + LDS_XB));
    const int tid = threadIdx.x, lane = tid & 63, wid = __builtin_amdgcn_readfirstlane(tid >> 6);
    const int bid = blockIdx.x, G = gridDim.x;
    unsigned char* ws = P.ws;
    bf16_t* XG = (bf16_t*)(ws + WS_XG);
    bf16_t* Qb = (bf16_t*)(ws + WS_Q); bf16_t* Kb = (bf16_t*)(ws + WS_K); bf16_t* Vb = (bf16_t*)(ws + WS_V);
    bf16_t* U2 = (bf16_t*)(ws + WS_U2); float* Z = (float*)(ws + WS_Z); bf16_t* Y = (bf16_t*)(ws + WS_Y); bf16_t* MG = (bf16_t*)(ws + WS_MG);
    bf16_t* H = (bf16_t*)(ws + WS_H); float* NUM = (float*)(ws + WS_NUM); float* ML = (float*)(ws + WS_ML); float* SSQ = (float*)(ws + WS_SSQ);
#define GSYNC0() do { asm volatile("s_waitcnt vmcnt(0) lgkmcnt(0)" ::: "memory"); grid.sync(); } while (0)
#define GSYNC() xcd_barrier(xb)
#define GGROUP() group_barrier(xb.bar, gpm)

    {
        {
            const float* x = P.in[0];
            for (int row = bid * 8 + wid; row < SEQ; row += G * 8) {
                float ss = 0.f;
#pragma unroll
                for (int i = 0; i < 8; ++i) { const int c = lane * 4 + 256 * i; const f32x4 v = *(const f32x4*)(x + (size_t)row * DM + c);
                    u32x2 w; w.x = cvt_pk_bf16(v[0], v[1]); w.y = cvt_pk_bf16(v[2], v[3]);
                    const float r0 = bf_lo(w.x), r1 = bf_hi(w.x), r2 = bf_lo(w.y), r3 = bf_hi(w.y); ss += (r0 * r0 + r1 * r1) + (r2 * r2 + r3 * r3);
                    *(u32x2*)(XG + (size_t)row * DM + c) = w; }
                ss += __shfl_xor(ss, 32);
                if (lane < 32) SSQ[(size_t)row * 32 + lane] = ss;
            }
        }
        for (int it = bid; it < 128; it += G) { s5_gen(lds, P, it >> 6, it & 63);
        }
        {
            constexpr int NBATCH = T_ALL / 4, NB1 = 9216;
            if (G > 128) {
                if (bid >= 128) for (int bt = (bid - 128) * 8 + wid; bt < NB1; bt += (G - 128) * 8) {
#pragma unroll 1
                    for (int q = 0; q < 4; ++q) conv_dispatch(P, bt * 4 + q, lane); }
                for (int bt = NB1 + bid * 8 + wid; bt < NBATCH; bt += G * 8) {
#pragma unroll 1
                    for (int q = 0; q < 4; ++q) conv_dispatch(P, bt * 4 + q, lane); }
            } else {
                for (int bt = bid * 8 + wid; bt < NBATCH; bt += G * 8) {
#pragma unroll 1
                    for (int q = 0; q < 4; ++q) conv_dispatch(P, bt * 4 + q, lane); }
            }
        }
    }
    GSYNC0();

    const int gpm = 8 * ((bid & 7) >> 1) + ((bid >> 3) & 7);
    for (int layer = 0; layer < 4; ++layer) {
        const int j = layer >> 1; const bool odd = layer & 1;
        const float* ssq_mix = SSQ + (size_t)(2 * layer) * SEQ * 32; float* ssq_mlp = SSQ + (size_t)(2 * layer + 1) * SEQ * 32; float* ssq_nxt = SSQ + (size_t)(2 * layer + 2) * SEQ * 32;
        {
            Gemm gm; gm.A = XG; gm.Bt = odd ? (const bf16_t*)(ws + WS_QKV + j * SZ_QKV) : (const bf16_t*)(ws + WS_WIN + j * SZ_WIN); gm.lda = DM; gm.ldb = DM; gm.K = DM;
            StaticOrder S; S.init(SEQ, odd ? 6144 : 4096, G, bid);
            EpiIn E; E.Q = Qb; E.K = Kb; E.V = Vb; E.U2 = U2; E.ssq = ssq_mix; E.shift = odd ? 11 : 10; E.ldq = odd ? 2048 : 1024;
            gemm_phase<EpiIn, StaticOrder>(lds, gm, S, E);
        }
        GSYNC();
        if (!odd) {
            {
                Gemm gm; gm.A = U2; gm.Bt = (const bf16_t*)(ws + WS_B1 + j * SZ_B1); gm.lda = 768; gm.ldb = 512; gm.K = 512;
                ListOrder S; S.total = 64; S.G = 64; S.c = bid; S.mode = 0;
                EpiP1 E; E.Z = Z;
                gemm_phase<EpiP1, ListOrder>(lds, gm, S, E);
                if (bid < 64) {
                    asm volatile("s_waitcnt vmcnt(0)" ::: "memory"); __syncthreads();
                    __builtin_amdgcn_fence(__ATOMIC_ACQUIRE, "agent"); asm volatile("s_waitcnt vmcnt(0)" ::: "memory");
                    s5_carry2(P, j, bid);
                    asm volatile("s_waitcnt vmcnt(0)" ::: "memory"); __syncthreads();
                    __builtin_amdgcn_fence(__ATOMIC_ACQUIRE, "agent"); asm volatile("s_waitcnt vmcnt(0)" ::: "memory"); __syncthreads();
                    Gemm g3; g3.A = U2; g3.Bt = (const bf16_t*)(ws + WS_B3 + j * SZ_B3); g3.lda = 768; g3.ldb = 768; g3.K = 768;
                    ListOrder S3; S3.total = 128; S3.G = 64; S3.c = bid; S3.mode = 2;
                    EpiP3 E3; E3.Y = Y;
                    gemm_phase<EpiP3, ListOrder>(lds, g3, S3, E3);
                } else {
                    attn_a_phase(lds, bid - 64, 192, 8, Qb, Kb, Vb, P.in[1], NUM, ML);
                }
            }
            GSYNC();
            {
                Gemm gm; gm.A = Y; gm.Bt = (const bf16_t*)(ws + WS_GLU + j * SZ_GLU); gm.lda = 1024; gm.ldb = 1024; gm.K = 1024;
                StaticOrder S; S.init(SEQ, 1024, G, bid);
                EpiGlu E; E.Y = Y; E.MG = MG;
                gemm_phase<EpiGlu, StaticOrder>(lds, gm, S, E);
                if (bid >= 128) attn_a_merge(NUM, ML, MG, (bid - 128) * NTHR + tid, 128 * NTHR, 0, MERGE_ITEMS);
            }
            GSYNC();
        } else {
            attn_c_phase(lds, bid, G, Qb, Kb, Vb, P.in[15] + (size_t)j * 16 * 465, MG);
            GSYNC();
        }
        {
            Gemm gm; gm.A = MG; gm.Bt = odd ? (const bf16_t*)(ws + WS_COUT + j * SZ_WOUT) : (const bf16_t*)(ws + WS_WOUT + j * SZ_WOUT); gm.lda = DM; gm.ldb = DM; gm.K = DM;
            StaticOrder S; S.init(SEQ, DM, G, bid);
            EpiRes E; E.XB = XG; E.ssq_next = ssq_mlp;
            gemm_phase<EpiRes, StaticOrder>(lds, gm, S, E);
        }
        GGROUP();
        {
            Gemm gm; gm.A = XG; gm.Bt = (const bf16_t*)(ws + WS_W1 + layer * SZ_W1); gm.lda = DM; gm.ldb = DM; gm.K = DM;
            StaticOrder S; S.init(SEQ, DFF, G, bid);
            EpiH E; E.H = H; E.ssq = ssq_mlp;
            gemm_phase<EpiH, StaticOrder>(lds, gm, S, E);
        }
        GGROUP();
        {
            Gemm gm; gm.A = H; gm.Bt = (const bf16_t*)(ws + WS_W2 + layer * SZ_W2); gm.lda = DFF; gm.ldb = DFF; gm.K = DFF;
            StaticOrder S; S.init(SEQ, DM, G, bid);
            EpiRes E; E.XB = XG; E.ssq_next = ssq_nxt;
            gemm_phase<EpiRes, StaticOrder>(lds, gm, S, E);
        }
        if (layer < 3) GGROUP(); else GSYNC();
    }
    {
        const float* ssq = SSQ + (size_t)8 * SEQ * 32; const float* gf = P.in[20];
        for (int row = bid * 8 + wid; row < SEQ; row += G * 8) {
            const float rs = row_rstd(ssq, row);
#pragma unroll
            for (int i = 0; i < 8; ++i) { const int c = lane * 4 + 256 * i;
                const u32x2 xw = *(const u32x2*)(XG + (size_t)row * DM + c); const f32x4 gv = *(const f32x4*)(gf + c);
                f32x4 v; v[0] = bf_lo(xw.x); v[1] = bf_hi(xw.x); v[2] = bf_lo(xw.y); v[3] = bf_hi(xw.y);
                *(f32x4*)(P.out + (size_t)row * DM + c) = v * rs * gv; }
        }
    }
}

extern "C" void kernel_launch(void* const* d_in, const int* in_sizes, int n_in, void* d_out, int out_size, void* d_ws, size_t ws_size, hipStream_t stream) {
    static int grid = 0;
    if (grid == 0) {
        if (n_in != 21 || ws_size < WS_END) { fprintf(stderr, "kernel_launch: need 21 inputs and %zu bytes of workspace (got %d, %zu)\n", (size_t)WS_END, n_in, ws_size); grid = -1; return; }
        int dev = 0, cus = 0, per_cu = 0;
        hipGetDevice(&dev); hipDeviceGetAttribute(&cus, hipDeviceAttributeMultiprocessorCount, dev);
        if (hipFuncSetAttribute((const void*)hybrid_encoder_fwd, hipFuncAttributeMaxDynamicSharedMemorySize, LDS_BYTES) != hipSuccess) { fprintf(stderr, "kernel_launch: hipFuncSetAttribute failed\n"); grid = -1; return; }
        if (hipOccupancyMaxActiveBlocksPerMultiprocessor(&per_cu, (const void*)hybrid_encoder_fwd, NTHR, LDS_BYTES) != hipSuccess || per_cu < 1) { fprintf(stderr, "kernel_launch: occupancy query says %d blocks/CU\n", per_cu); per_cu = 1; }
        (void)hipGetLastError();
        grid = cus;
    }
    if (grid < 0) return;
    hipMemsetAsync((char*)d_ws + WS_CTRL, 0, 16384, stream);
    Params p{};
    for (int i = 0; i < 21; ++i) p.in[i] = (const float*)d_in[i];
    p.out = (float*)d_out; p.ws = (unsigned char*)d_ws; p.coop = 1; p.pad = 0;
    void* args[] = {&p};
    hipError_t e = hipLaunchCooperativeKernel((const void*)hybrid_encoder_fwd, dim3(grid), dim3(NTHR), args, LDS_BYTES, stream);
    if (e != hipSuccess) fprintf(stderr, "cooperative launch failed: %s (grid %d)\n", hipGetErrorString(e), grid);
}
```

```cpp
#include <hip/hip_runtime.h>
#include <hip/hip_cooperative_groups.h>
#include <cstdio>
namespace cg = cooperative_groups;

#define LAS __attribute__((address_space(3)))
typedef unsigned short bf16_t;
typedef short bf16x8 __attribute__((ext_vector_type(8)));
typedef short s16x4 __attribute__((ext_vector_type(4)));
typedef float f32x4 __attribute__((ext_vector_type(4)));
typedef float f32x2 __attribute__((ext_vector_type(2)));
typedef unsigned u32x4 __attribute__((ext_vector_type(4)));
typedef unsigned u32x2 __attribute__((ext_vector_type(2)));

constexpr int SEQ = 8192, DM = 2048, DFF = 8192;
constexpr float RMS_EPS = 1e-6f;
constexpr int NTHR = 512;

constexpr size_t SZ_WIN = (size_t)4096 * 2048 * 2, SZ_WOUT = (size_t)2048 * 2048 * 2, SZ_GLU = (size_t)1024 * 1024 * 2;
constexpr size_t SZ_QKV = (size_t)6144 * 2048 * 2, SZ_W1 = (size_t)8192 * 2048 * 2, SZ_W2 = SZ_W1;
constexpr size_t SZ_B3 = (size_t)64 * 512 * 768 * 2, SZ_B1 = (size_t)64 * 256 * 512 * 2;
constexpr size_t WS_CTRL = 0;
constexpr size_t WS_WIN = 16384;
constexpr size_t WS_WOUT = WS_WIN + 2 * SZ_WIN;
constexpr size_t WS_GLU = WS_WOUT + 2 * SZ_WOUT;
constexpr size_t WS_QKV = WS_GLU + 2 * SZ_GLU;
constexpr size_t WS_COUT = WS_QKV + 2 * SZ_QKV;
constexpr size_t WS_W1 = WS_COUT + 2 * SZ_WOUT;
constexpr size_t WS_W2 = WS_W1 + 4 * SZ_W1;
constexpr size_t WS_B3 = WS_W2 + 4 * SZ_W2;
constexpr size_t WS_B1 = WS_B3 + 2 * SZ_B3;
constexpr size_t WS_X = WS_B1 + 2 * SZ_B1;
constexpr size_t WS_XG = WS_X + (size_t)SEQ * DM * 4;
constexpr size_t WS_Q = WS_XG + (size_t)SEQ * DM * 2;
constexpr size_t WS_K = WS_Q + (size_t)SEQ * DM * 2;
constexpr size_t WS_V = WS_K + (size_t)SEQ * DM * 2;
constexpr size_t WS_U2 = WS_V + (size_t)SEQ * DM * 2;
constexpr size_t WS_Z = WS_U2 + (size_t)64 * 256 * 768 * 2;
constexpr size_t WS_Y = WS_Z + (size_t)64 * 256 * 256 * 4;
constexpr size_t WS_MG = WS_Y + (size_t)SEQ * 1024 * 2;
constexpr size_t WS_H = WS_MG + (size_t)SEQ * DM * 2;
constexpr size_t WS_NUM = WS_H;
constexpr size_t WS_ML = WS_H + (size_t)SEQ * DFF * 2;
constexpr size_t WS_SSQ = WS_ML + (size_t)3 * 8 * SEQ * 8;
constexpr size_t WS_A32 = WS_SSQ + (size_t)9 * SEQ * 32 * 4;
constexpr size_t WS_END = WS_A32 + (size_t)2 * 2 * 64 * 64 * 8;

struct Params { const float* in[21]; float* out; unsigned char* ws; int coop; int pad; };

__device__ __forceinline__ unsigned cvt_pk_bf16(float lo, float hi) { unsigned r; asm volatile("v_cvt_pk_bf16_f32 %0, %1, %2" : "=v"(r) : "v"(lo), "v"(hi)); return r; }
__device__ __forceinline__ unsigned cvt_pk_bf16_t(float lo, float hi) { unsigned r; asm volatile("s_nop 1\n\tv_cvt_pk_bf16_f32 %0, %1, %2" : "=v"(r) : "v"(lo), "v"(hi)); return r; }
__device__ __forceinline__ unsigned cvt_pk_sw(float lo, float hi) { unsigned a = __float_as_uint(lo), b = __float_as_uint(hi); a += 0x7fffu + ((a >> 16) & 1u); b += 0x7fffu + ((b >> 16) & 1u); return (a >> 16) | (b & 0xffff0000u); }
__device__ __forceinline__ float bf_lo(unsigned w) { return __uint_as_float(w << 16); }
__device__ __forceinline__ float bf_hi(unsigned w) { return __uint_as_float(w & 0xffff0000u); }

__device__ __forceinline__ float row_rstd(const float* ssqp, int row) {
    const f32x4* p = (const f32x4*)(ssqp + (size_t)row * 32); f32x4 a = p[0];
#pragma unroll
    for (int i = 1; i < 8; ++i) a += p[i];
    return rsqrtf(((a[0] + a[1]) + (a[2] + a[3])) * (1.0f / DM) + RMS_EPS);
}
constexpr int BM = 256, BK = 64, HALF = 128, HTB = HALF * BK * 2, STAGE_BYTES = 8 * HTB, NXCD = 8, WGM = 8;
__device__ __forceinline__ int lds_byte(int r, int c) { const int st = (r >> 4) * 2 + (c >> 5), rr = r & 15, cc = c & 31, ob = rr * 64 + cc * 2; return st * 1024 + (ob ^ (((ob >> 9) & 1) << 5)); }
__device__ __forceinline__ void stage_rc(int b, int& R, int& C) { const int st = b / 1024, sb = b % 1024, swz = sb ^ (((sb >> 9) & 1) << 5); R = (st >> 1) * 16 + swz / 64; C = (st & 1) * 32 + (swz % 64) / 2; }
__device__ __forceinline__ int perm32(int rho) { const int n = rho >> 4, i = rho & 15; return 8 * (i >> 2) + 4 * n + (i & 3); }

struct Unit { int pm, pn; };
struct Gemm { const bf16_t* A; const bf16_t* Bt; int lda, ldb, K; };

struct StaticOrder {
    int nM, nN, nwg, G, c;
    __device__ void init(int M, int N, int G_, int c_) { nM = M / BM; nN = N / BM; nwg = nM * nN; G = G_; c = c_; }
    __device__ bool next(int i, Unit& u) const {
        const long L = (long)i * G + c; if (L >= nwg) return false;
        int wgid = (int)L; { const int q = nwg / NXCD, r = nwg % NXCD, xcd = wgid % NXCD, off = wgid / NXCD; wgid = (xcd < r ? xcd * (q + 1) : r * (q + 1) + (xcd - r) * q) + off; }
        const int nig = WGM * nN, gid = wgid / nig, fm = gid * WGM, gsz = (nM - fm) < WGM ? (nM - fm) : WGM;
        u.pm = fm + ((wgid % nig) % gsz); u.pn = (wgid % nig) / gsz; return true;
    }
};
struct ListOrder {
    int total, G, c, mode;
    __device__ bool next(int i, Unit& u) const {
        if (mode == 2) { if (c >= G || i >= 2) return false; u.pm = c; u.pn = 2 * c + i; return true; }
        const int L = i * G + c; if (c >= G || L >= total) return false; if (mode == 0) { u.pm = L; u.pn = L; } else { u.pm = L >> 1; u.pn = L; } return true; }
};


struct EpiIn {
    static constexpr bool PERM = true, NEEDS_RSTD = true;
    bf16_t* Q; bf16_t* K; bf16_t* V; bf16_t* U2; const float* ssq; int shift, ldq;
    __device__ __forceinline__ void operator()(const f32x4 (&acc)[2][2][4][2], const Unit& u, int ui, const LAS float* rtab, int wr, int wc, int fr, int fq) const {
        const int row0 = u.pm * BM + wr * 64 + fr; const int colt = u.pn * BM; const int t = colt >> shift; const int lc0 = (colt & ((1 << shift) - 1)) + wc * 32 + 8 * fq;
        bf16_t* base = (t == 0) ? Q : ((t == 1) ? K : V);
#pragma unroll
        for (int ai = 0; ai < 2; ++ai)
#pragma unroll
            for (int m = 0; m < 4; ++m) {
                const int row = row0 + ai * HALF + m * 16; const float rs = rtab[ui * 256 + wr * 64 + fr + ai * HALF + m * 16];
#pragma unroll
                for (int bj = 0; bj < 2; ++bj) {
                    const int lc = lc0 + bj * HALF; const f32x4 v0 = acc[ai][bj][m][0] * rs, v1 = acc[ai][bj][m][1] * rs;
                    u32x4 w; w.x = cvt_pk_bf16(v0[0], v0[1]); w.y = cvt_pk_bf16(v0[2], v0[3]); w.z = cvt_pk_bf16(v1[0], v1[1]); w.w = cvt_pk_bf16(v1[2], v1[3]);
                    if (t < 3) *(u32x4*)(base + (size_t)row * ldq + lc) = w;
                    else { const int g = lc >> 4, c = lc & 15, n = row >> 5, tt = row & 31; *(u32x4*)(U2 + ((size_t)(g * 256 + n) * 768 + tt * 16 + c)) = w; }
                }
            }
    }
};
struct EpiRes {
    static constexpr bool PERM = true, NEEDS_RSTD = false;
    bf16_t* XB; float* ssq_next;
    __device__ __forceinline__ void operator()(const f32x4 (&acc)[2][2][4][2], const Unit& u, int ui, const LAS float* rtab, int wr, int wc, int fr, int fq) const {
        const int row0 = u.pm * BM + wr * 64 + fr, col0 = u.pn * BM + wc * 32 + 8 * fq;
#pragma unroll
        for (int ai = 0; ai < 2; ++ai) {
            u32x4 xv[4][2];
#pragma unroll
            for (int m = 0; m < 4; ++m)
#pragma unroll
                for (int bj = 0; bj < 2; ++bj) xv[m][bj] = *(const u32x4*)(XB + (size_t)(row0 + ai * HALF + m * 16) * DM + col0 + bj * HALF);
#pragma unroll
            for (int m = 0; m < 4; ++m) { const int row = row0 + ai * HALF + m * 16; float ss = 0.f;
#pragma unroll
                for (int bj = 0; bj < 2; ++bj) {
                    const f32x4 a0 = acc[ai][bj][m][0], a1 = acc[ai][bj][m][1]; const u32x4 xo = xv[m][bj]; u32x4 w;
                    w.x = cvt_pk_bf16(bf_lo(xo.x) + a0[0], bf_hi(xo.x) + a0[1]); w.y = cvt_pk_bf16(bf_lo(xo.y) + a0[2], bf_hi(xo.y) + a0[3]);
                    w.z = cvt_pk_bf16(bf_lo(xo.z) + a1[0], bf_hi(xo.z) + a1[1]); w.w = cvt_pk_bf16(bf_lo(xo.w) + a1[2], bf_hi(xo.w) + a1[3]);
                    *(u32x4*)(XB + (size_t)row * DM + col0 + bj * HALF) = w;
#pragma unroll
                    for (int e = 0; e < 4; ++e) { const float lo = bf_lo(w[e]), hi = bf_hi(w[e]); ss += lo * lo + hi * hi; }
                }
                ss += __shfl_xor(ss, 16); ss += __shfl_xor(ss, 32);
                if (fq == 0) ssq_next[(size_t)row * 32 + (u.pn & 7) * 4 + wc] = ss; }
        }
    }
};
struct EpiH {
    static constexpr bool PERM = true, NEEDS_RSTD = true;
    bf16_t* H; const float* ssq;
    __device__ __forceinline__ void operator()(const f32x4 (&acc)[2][2][4][2], const Unit& u, int ui, const LAS float* rtab, int wr, int wc, int fr, int fq) const {
        const int row0 = u.pm * BM + wr * 64 + fr, col0 = u.pn * BM + wc * 32 + 8 * fq;
#pragma unroll
        for (int ai = 0; ai < 2; ++ai)
#pragma unroll
            for (int m = 0; m < 4; ++m) {
                const int row = row0 + ai * HALF + m * 16; const float rs = rtab[ui * 256 + wr * 64 + fr + ai * HALF + m * 16];
#pragma unroll
                for (int bj = 0; bj < 2; ++bj) {
                    f32x4 v0 = acc[ai][bj][m][0] * rs, v1 = acc[ai][bj][m][1] * rs;
#pragma unroll
                    for (int e = 0; e < 4; ++e) { const float a = fmaxf(v0[e], 0.f), b = fmaxf(v1[e], 0.f); v0[e] = a * a; v1[e] = b * b; }
                    u32x4 w; w.x = cvt_pk_bf16(v0[0], v0[1]); w.y = cvt_pk_bf16(v0[2], v0[3]); w.z = cvt_pk_bf16(v1[0], v1[1]); w.w = cvt_pk_bf16(v1[2], v1[3]);
                    *(u32x4*)(H + (size_t)row * DFF + col0 + bj * HALF) = w;
                }
            }
    }
};
struct EpiGlu {
    static constexpr bool PERM = true, NEEDS_RSTD = false;
    const bf16_t* Y; bf16_t* MG;
    __device__ __forceinline__ void operator()(const f32x4 (&acc)[2][2][4][2], const Unit& u, int ui, const LAS float* rtab, int wr, int wc, int fr, int fq) const {
        const int row0 = u.pm * BM + wr * 64 + fr, col0 = u.pn * BM + wc * 32 + 8 * fq;
#pragma unroll
        for (int ai = 0; ai < 2; ++ai)
#pragma unroll
            for (int m = 0; m < 4; ++m) {
                const int row = row0 + ai * HALF + m * 16;
#pragma unroll
                for (int bj = 0; bj < 2; ++bj) {
                    const int col = col0 + bj * HALF; const u32x4 yv = *(const u32x4*)(Y + (size_t)row * 1024 + col);
                    const f32x4 a0 = acc[ai][bj][m][0], a1 = acc[ai][bj][m][1]; float o[8];
                    const float yy[8] = {bf_lo(yv.x), bf_hi(yv.x), bf_lo(yv.y), bf_hi(yv.y), bf_lo(yv.z), bf_hi(yv.z), bf_lo(yv.w), bf_hi(yv.w)};
#pragma unroll
                    for (int e = 0; e < 4; ++e) { o[e] = yy[e] / (1.0f + __expf(-a0[e])); o[4 + e] = yy[4 + e] / (1.0f + __expf(-a1[e])); }
                    u32x4 w; w.x = cvt_pk_bf16(o[0], o[1]); w.y = cvt_pk_bf16(o[2], o[3]); w.z = cvt_pk_bf16(o[4], o[5]); w.w = cvt_pk_bf16(o[6], o[7]);
                    *(u32x4*)(MG + (size_t)row * DM + 1024 + col) = w;
                }
            }
    }
};
struct EpiP1 {
    static constexpr bool PERM = false, NEEDS_RSTD = false;
    float* Z;
    __device__ __forceinline__ void operator()(const f32x4 (&acc)[2][2][4][2], const Unit& u, int ui, const LAS float* rtab, int wr, int wc, int fr, int fq) const {
        const int row0 = u.pm * BM + wr * 64 + fr, col0 = wc * 32 + 4 * fq;
#pragma unroll
        for (int ai = 0; ai < 2; ++ai)
#pragma unroll
            for (int m = 0; m < 4; ++m) { float* rowp = Z + (size_t)(row0 + ai * HALF + m * 16) * 256 + col0;
#pragma unroll
                for (int bj = 0; bj < 2; ++bj)
#pragma unroll
                    for (int n = 0; n < 2; ++n) *(f32x4*)(rowp + bj * HALF + n * 16) = acc[ai][bj][m][n]; }
    }
};
__device__ __forceinline__ float gelu_tanh(float x) { const float z = 0.7978845608f * (x + 0.044715f * x * x * x); const float th = 1.0f - 2.0f / (__expf(2.0f * z) + 1.0f); return 0.5f * x * (1.0f + th); }
struct EpiP3 {
    static constexpr bool PERM = true, NEEDS_RSTD = false;
    bf16_t* Y;
    __device__ __forceinline__ void operator()(const f32x4 (&acc)[2][2][4][2], const Unit& u, int ui, const LAS float* rtab, int wr, int wc, int fr, int fq) const {
        const int g = u.pm; const int n0 = wr * 64 + fr; const int lc0 = (u.pn & 1) * 256 + wc * 32 + 8 * fq;
#pragma unroll
        for (int ai = 0; ai < 2; ++ai)
#pragma unroll
            for (int m = 0; m < 4; ++m) {
                const int n = n0 + ai * HALF + m * 16;
#pragma unroll
                for (int bj = 0; bj < 2; ++bj) {
                    const int lc = lc0 + bj * HALF, t = lc >> 4, co = lc & 15; const int token = n * 32 + t;
                    const f32x4 a0 = acc[ai][bj][m][0], a1 = acc[ai][bj][m][1];
                    u32x4 w; w.x = cvt_pk_bf16(gelu_tanh(a0[0]), gelu_tanh(a0[1])); w.y = cvt_pk_bf16(gelu_tanh(a0[2]), gelu_tanh(a0[3]));
                    w.z = cvt_pk_bf16(gelu_tanh(a1[0]), gelu_tanh(a1[1])); w.w = cvt_pk_bf16(gelu_tanh(a1[2]), gelu_tanh(a1[3]));
                    *(u32x4*)(Y + (size_t)token * 1024 + 16 * g + co) = w;
                }
            }
    }
};

template <class Epi, class Sched>
__device__ __forceinline__ void gemm_phase(LAS unsigned char* lds, const Gemm g, const Sched& S, const Epi& E) {
    int tid = threadIdx.x; asm volatile("" : "+v"(tid));
    const int wid = __builtin_amdgcn_readfirstlane(tid >> 6), lane = tid & 63, wr = wid >> 2, wc = wid & 3, fr = lane & 15, fq = lane >> 4;
    const int K = g.K, nt = K / BK;
    unsigned voffA[2], voffB[2];
#pragma unroll
    for (int i = 0; i < 2; ++i) { int R, C; stage_rc(tid * 16 + i * 8192, R, C); const int Rb = Epi::PERM ? ((R & ~31) + perm32(R & 31)) : R;
        voffA[i] = (unsigned)(R * g.lda + C) * 2u; voffB[i] = (unsigned)(Rb * g.ldb + C) * 2u; }
    const size_t kstep = (size_t)(BK * 2);
    const size_t hstepA = (size_t)HALF * g.lda * 2, hstepB = (size_t)HALF * g.ldb * 2;
    const size_t tstepA = 2 * hstepA, tstepB = 2 * hstepB;
    const unsigned ldsw = (unsigned)wid * 1024u;
    const int aoff = lds_byte(wr * 64 + fr, fq * 8), boff = lds_byte(wc * 32 + fr, fq * 8);
#define PG8_SA(b, h) (((b) * 2 + (h)) * HTB)
#define PG8_SB(b, h) ((4 + (b) * 2 + (h)) * HTB)
#define PG8_STAGE(bufoff, gbase, voff) do { _Pragma("unroll") for (int _i = 0; _i < 2; ++_i) \
        __builtin_amdgcn_global_load_lds((const unsigned*)((const char*)(gbase) + (voff)[_i]), (LAS unsigned*)(lds + (bufoff) + ldsw + _i * 8192), 16, 0, 0); } while (0)
#define PG8_LDA(dst, b, h) do { _Pragma("unroll") for (int m = 0; m < 4; ++m) _Pragma("unroll") for (int k = 0; k < 2; ++k) dst[m][k] = *(const LAS bf16x8*)(lds + PG8_SA(b, h) + aoff + m * 2048 + k * 1024); } while (0)
#define PG8_LDB(dst, b, h) do { _Pragma("unroll") for (int n = 0; n < 2; ++n) _Pragma("unroll") for (int k = 0; k < 2; ++k) dst[n][k] = *(const LAS bf16x8*)(lds + PG8_SB(b, h) + boff + n * 2048 + k * 1024); } while (0)
#define PG8_MMA(ai, bj, At, Bt) do { __builtin_amdgcn_s_setprio(1); _Pragma("unroll") for (int m = 0; m < 4; ++m) _Pragma("unroll") for (int n = 0; n < 2; ++n) _Pragma("unroll") for (int k = 0; k < 2; ++k) \
        acc[ai][bj][m][n] = __builtin_amdgcn_mfma_f32_16x16x32_bf16(Bt[n][k], At[m][k], acc[ai][bj][m][n], 0, 0, 0); __builtin_amdgcn_s_setprio(0); } while (0)
#define PG8_WAIT_V(n) asm volatile("s_waitcnt vmcnt(" #n ")" ::: "memory")
#define PG8_WAIT_L(n) asm volatile("s_waitcnt lgkmcnt(" #n ")" ::: "memory")
#define PG8_BAR __builtin_amdgcn_s_barrier()
#define PG8_SCHED __builtin_amdgcn_sched_barrier(0)
    Unit cur, nxt; int ui = 0;
    if (!S.next(0, cur)) return;

    f32x4 acc[2][2][4][2];
#pragma unroll
    for (int a = 0; a < 2; ++a)
#pragma unroll
        for (int b = 0; b < 2; ++b)
#pragma unroll
            for (int m = 0; m < 4; ++m)
#pragma unroll
                for (int n = 0; n < 2; ++n) acc[a][b][m][n] = (f32x4){0.f, 0.f, 0.f, 0.f};
    bf16x8 At[4][2], B0[2][2], B1[2][2];
    const char* cA = (const char*)g.A + (size_t)cur.pm * tstepA; const char* cB = (const char*)g.Bt + (size_t)cur.pn * tstepB;
    PG8_STAGE(PG8_SB(0, 0), cB, voffB); PG8_STAGE(PG8_SA(0, 0), cA, voffA); PG8_STAGE(PG8_SB(0, 1), cB + hstepB, voffB); PG8_STAGE(PG8_SA(0, 1), cA + hstepA, voffA);
    if constexpr (Epi::NEEDS_RSTD) {
        LAS float* rt = (LAS float*)(lds + STAGE_BYTES);
        for (int i = tid >> 8; i < 4; i += 2) { Unit uu; if (!S.next(i, uu)) break; rt[i * 256 + (tid & 255)] = row_rstd(E.ssq, uu.pm * BM + (tid & 255)); }
        __syncthreads();
    }
    if (wr == 1) PG8_BAR;
    PG8_WAIT_V(4); PG8_BAR;
    PG8_STAGE(PG8_SB(1, 0), cB + kstep, voffB); PG8_STAGE(PG8_SA(1, 0), cA + kstep, voffA); PG8_STAGE(PG8_SB(1, 1), cB + hstepB + kstep, voffB);
    PG8_WAIT_V(6); PG8_BAR;
    for (;;) {
        const bool has_next = S.next(ui + 1, nxt);
        const char* nA = has_next ? (const char*)g.A + (size_t)nxt.pm * tstepA : cA; const char* nB = has_next ? (const char*)g.Bt + (size_t)nxt.pn * tstepB : cB;
        for (int t = 0; t < nt; t += 2) {
            const bool last = (t == nt - 2);
            const char* a1 = cA + (size_t)(t + 1) * kstep;
            const char* a2 = last ? nA : cA + (size_t)(t + 2) * kstep; const char* b2 = last ? nB : cB + (size_t)(t + 2) * kstep;
            const char* a3 = a2 + kstep; const char* b3 = b2 + kstep;
            PG8_LDB(B0, 0, 0); PG8_SCHED; PG8_LDA(At, 0, 0); PG8_STAGE(PG8_SA(1, 1), a1 + hstepA, voffA);
            PG8_WAIT_L(8); PG8_BAR; PG8_WAIT_L(0); PG8_MMA(0, 0, At, B0); PG8_BAR; PG8_SCHED;
            PG8_LDB(B1, 0, 1); PG8_STAGE(PG8_SB(0, 0), b2, voffB);
            PG8_BAR; PG8_WAIT_L(0); PG8_MMA(0, 1, At, B1); PG8_BAR;
            PG8_LDA(At, 0, 1); PG8_STAGE(PG8_SA(0, 0), a2, voffA);
            PG8_BAR; PG8_WAIT_L(0); PG8_MMA(1, 0, At, B0); PG8_BAR; PG8_SCHED;
            PG8_STAGE(PG8_SB(0, 1), b2 + hstepB, voffB);
            PG8_WAIT_V(6); PG8_BAR; PG8_MMA(1, 1, At, B1); PG8_BAR;
            PG8_LDB(B0, 1, 0); PG8_SCHED; PG8_LDA(At, 1, 0); PG8_STAGE(PG8_SA(0, 1), a2 + hstepA, voffA);
            PG8_WAIT_L(8); PG8_BAR; PG8_WAIT_L(0); PG8_MMA(0, 0, At, B0); PG8_BAR; PG8_SCHED;
            PG8_LDB(B1, 1, 1); PG8_STAGE(PG8_SB(1, 0), b3, voffB);
            PG8_BAR; PG8_WAIT_L(0); PG8_MMA(0, 1, At, B1); PG8_BAR;
            PG8_LDA(At, 1, 1); PG8_STAGE(PG8_SA(1, 0), a3, voffA);
            PG8_BAR; PG8_WAIT_L(0); PG8_MMA(1, 0, At, B0); PG8_BAR; PG8_SCHED;
            PG8_STAGE(PG8_SB(1, 1), b3 + hstepB, voffB);
            PG8_WAIT_V(6); PG8_BAR; PG8_MMA(1, 1, At, B1); PG8_BAR;
        }
        E(acc, cur, ui, (const LAS float*)(lds + STAGE_BYTES), wr, wc, fr, fq);
        if (!has_next) break;
#pragma unroll
        for (int a = 0; a < 2; ++a)
#pragma unroll
            for (int b = 0; b < 2; ++b)
#pragma unroll
                for (int m = 0; m < 4; ++m)
#pragma unroll
                    for (int n = 0; n < 2; ++n) acc[a][b][m][n] = (f32x4){0.f, 0.f, 0.f, 0.f};
        cur = nxt; cA = nA; cB = nB; ++ui;
    }
    PG8_WAIT_V(0);
    if (wr == 0) PG8_BAR;
    PG8_BAR;
#undef PG8_SA
#undef PG8_SB
#undef PG8_STAGE
#undef PG8_LDA
#undef PG8_LDB
#undef PG8_MMA
#undef PG8_WAIT_V
#undef PG8_WAIT_L
#undef PG8_BAR
#undef PG8_SCHED
}

__device__ __forceinline__ void conv_issue(const float* src, int N, int tile, int lane, f32x4 (&v)[8]) {
    const int tn = N >> 5; const int k0 = (tile / tn) * 64, n0 = (tile % tn) * 32; const int kg = lane & 7, jn = lane >> 3;
    const float* sp = src + (size_t)(k0 + 8 * kg) * N + n0 + 4 * jn;
#pragma unroll
    for (int r = 0; r < 8; ++r) v[r] = *(const f32x4*)(sp + (size_t)r * N);
}
__device__ __forceinline__ void conv_finish(bf16_t* dst, int K, int N, int tile, int lane, f32x4 (&v)[8], const float* gk) {
    const int tn = N >> 5; const int k0 = (tile / tn) * 64, n0 = (tile % tn) * 32; const int kg = lane & 7, jn = lane >> 3;
    if (gk) { const f32x4 g0 = *(const f32x4*)(gk + k0 + 8 * kg), g1 = *(const f32x4*)(gk + k0 + 8 * kg + 4);
#pragma unroll
        for (int r = 0; r < 4; ++r) { v[r] *= g0[r]; v[4 + r] *= g1[r]; } }
#pragma unroll
    for (int i = 0; i < 4; ++i) { u32x4 w; w.x = cvt_pk_bf16(v[0][i], v[1][i]); w.y = cvt_pk_bf16(v[2][i], v[3][i]); w.z = cvt_pk_bf16(v[4][i], v[5][i]); w.w = cvt_pk_bf16(v[6][i], v[7][i]);
        *(u32x4*)(dst + (size_t)(n0 + 4 * jn + i) * K + k0 + 8 * kg) = w; }
}
constexpr int KSTR = 272, VSTR = 288, AROWS = 272;
constexpr int LDSA_K = 0, LDSA_V = AROWS * KSTR, LDS_TAB = LDSA_V + AROWS * VSTR;
constexpr int LDSC_V = 0, LDSC_K = 192 * VSTR;
constexpr int LDS_BYTES = LDS_TAB + 2048;

constexpr float LOG2E = 1.4426950408889634f, LN2 = 0.6931471805599453f, DEFER_THR = 11.0f;
typedef short v4i16_t __attribute__((ext_vector_type(4)));
__device__ __forceinline__ s16x4 tr_read(LAS const unsigned char* p) { return __builtin_bit_cast(s16x4, __builtin_amdgcn_ds_read_tr16_b64_v4i16((LAS v4i16_t*)p)); }

__device__ __forceinline__ void store_o_rows(bf16_t* rowp, const f32x4 (&O)[8], float inv, int g) {
    bf16_t* p = rowp + 4 * (g & ~1) + 16 * (g & 1);
#pragma unroll
    for (int k = 0; k < 4; ++k) {
        const f32x4 e = O[2 * k] * inv, o = O[2 * k + 1] * inv;
        const unsigned e0 = cvt_pk_bf16(e[0], e[1]), e1 = cvt_pk_bf16(e[2], e[3]), o0 = cvt_pk_bf16(o[0], o[1]), o1 = cvt_pk_bf16(o[2], o[3]);
        auto r0 = __builtin_amdgcn_permlane16_swap(e0, o0, false, false);
        auto r1 = __builtin_amdgcn_permlane16_swap(e1, o1, false, false);
        u32x4 w; w.x = r0[0]; w.y = r1[0]; w.z = r0[1]; w.w = r1[1];
        *(u32x4*)(p + 32 * k) = w;
    }
}
template <int LDS_K>
__device__ __forceinline__ void attn_qk(LAS const unsigned char* lds, int rowa, int rowb, const bf16x8 (&qf)[4], int lane, f32x4& sa, f32x4& sb) {
    const int fr = lane & 15, g = lane >> 4;
    sa = (f32x4){0.f, 0.f, 0.f, 0.f}; sb = sa;
    LAS const unsigned char* pa = lds + LDS_K + (rowa + fr) * KSTR + g * 16;
    LAS const unsigned char* pb = lds + LDS_K + (rowb + fr) * KSTR + g * 16;
#pragma unroll
    for (int s = 0; s < 4; ++s) {
        const bf16x8 ka = *(const LAS bf16x8*)(pa + s * 64), kb = *(const LAS bf16x8*)(pb + s * 64);
        sa = __builtin_amdgcn_mfma_f32_16x16x32_bf16(ka, qf[s], sa, 0, 0, 0);
        sb = __builtin_amdgcn_mfma_f32_16x16x32_bf16(kb, qf[s], sb, 0, 0, 0);
    }
}
template <int LDS_V>
__device__ __forceinline__ void attn_pv(LAS const unsigned char* lds, int rowa, int rowb, const f32x4 sa, const f32x4 sb, f32x4 (&O)[8], float& m_run, float& l_run, int lane) {
    const int g = lane >> 4, ii = lane & 15;
    float mx = fmaxf(fmaxf(fmaxf(sa[0], sa[1]), fmaxf(sa[2], sa[3])), fmaxf(fmaxf(sb[0], sb[1]), fmaxf(sb[2], sb[3])));
    if (__builtin_amdgcn_ballot_w64(mx > m_run + DEFER_THR) != 0ull) {
        mx = fmaxf(mx, __shfl_xor(mx, 16)); mx = fmaxf(mx, __shfl_xor(mx, 32));
        const float m_new = fmaxf(m_run, mx);
        const float alpha = __builtin_amdgcn_exp2f(m_run - m_new);
        l_run *= alpha; m_run = m_new;
#pragma unroll
        for (int cb = 0; cb < 8; ++cb) O[cb] *= alpha;
    }
    float pa[4], pb[4]; float sum = 0.f;
#pragma unroll
    for (int j = 0; j < 4; ++j) { pa[j] = __builtin_amdgcn_exp2f(sa[j] - m_run); pb[j] = __builtin_amdgcn_exp2f(sb[j] - m_run); sum += pa[j] + pb[j]; }
    l_run += sum;
    u32x4 pw; pw.x = cvt_pk_bf16_t(pa[0], pa[1]); pw.y = cvt_pk_bf16_t(pa[2], pa[3]); pw.z = cvt_pk_bf16_t(pb[0], pb[1]); pw.w = cvt_pk_bf16_t(pb[2], pb[3]);
    const bf16x8 pf = __builtin_bit_cast(bf16x8, pw);
    LAS const unsigned char* va = lds + LDS_V + (rowa + 4 * g + (ii >> 2)) * VSTR + (ii & 3) * 8;
    LAS const unsigned char* vb = lds + LDS_V + (rowb + 4 * g + (ii >> 2)) * VSTR + (ii & 3) * 8;
#pragma unroll
    for (int cb = 0; cb < 8; ++cb) {
        const s16x4 lo = tr_read(va + cb * 32), hi = tr_read(vb + cb * 32);
        bf16x8 vf; vf[0] = lo[0]; vf[1] = lo[1]; vf[2] = lo[2]; vf[3] = lo[3]; vf[4] = hi[0]; vf[5] = hi[1]; vf[6] = hi[2]; vf[7] = hi[3];
        O[cb] = __builtin_amdgcn_mfma_f32_16x16x32_bf16(vf, pf, O[cb], 0, 0, 0);
    }
}

struct AItem { int bi, h, b, d, r, nb, L; };
__device__ __forceinline__ AItem a_decode(int item) { AItem a; a.bi = item & 63; a.h = (item >> 6) & 7; a.b = item >> 9; const int sh = 2 * a.b; a.d = 1 << sh; a.r = a.bi & (a.d - 1); a.nb = a.bi >> sh; a.L = SEQ >> sh; return a; }
__device__ __forceinline__ void a_load(int item, int tid, const bf16_t* Kb, const bf16_t* Vb, u32x4 (&kv)[8], u32x4 (&vv)[8]) {
    const AItem a = a_decode(item);
#pragma unroll
    for (int it = 0; it < 8; ++it) {
        const int cid = tid + NTHR * it, row = cid >> 4, ch = cid & 15; const int l = a.nb * 128 + row - 64;
        if (l >= 0 && l < a.L) { const size_t off = ((size_t)(l * a.d + a.r) * 1024 + a.h * 128 + ch * 8); kv[it] = *(const u32x4*)(Kb + off); vv[it] = *(const u32x4*)(Vb + off); }
        else { kv[it] = (u32x4){0u, 0u, 0u, 0u}; vv[it] = kv[it]; }
    }
}
__device__ __forceinline__ void a_store(LAS unsigned char* lds, int item, int tid, const float* t5, const u32x4 (&kv)[8], const u32x4 (&vv)[8]) {
    const AItem a = a_decode(item); LAS float* tab = (LAS float*)(lds + LDS_TAB);
#pragma unroll
    for (int it = 0; it < 8; ++it) { const int cid = tid + NTHR * it, row = cid >> 4, ch = cid & 15;
        *(LAS u32x4*)(lds + LDSA_K + row * KSTR + ch * 16) = kv[it]; *(LAS u32x4*)(lds + LDSA_V + row * VSTR + ch * 16) = vv[it]; }
    if (tid < 129) { const int rel = (tid - 64) * a.d; const int n = rel < 0 ? -rel : rel; int bk;
        if (n < 8) bk = n; else { int lg = 8 + (int)(logf((float)n / 8.0f) / 4.852030263919617f * 8.0f); bk = lg < 15 ? lg : 15; }
        if (rel > 0) bk += 16;
        tab[tid] = t5[bk * 8 + a.h] * LOG2E; }
}
__device__ __forceinline__ void a_compute(LAS unsigned char* lds, int item, int tid, const bf16x8 (&qf)[4], float* NUM, float* ML) {
    const int wid = __builtin_amdgcn_readfirstlane(tid >> 6), lane = tid & 63, fr = lane & 15, g = lane >> 4;
    const AItem a = a_decode(item); const int nb = a.nb, L = a.L, d = a.d, r = a.r, h = a.h, b = a.b;
    LAS float* tab = (LAS float*)(lds + LDS_TAB);
    const int i0 = 16 * wid, qi = i0 + fr; const int qpos = (nb * 128 + qi) * d + r;
    f32x4 O[8];
#pragma unroll
    for (int cb = 0; cb < 8; ++cb) O[cb] = (f32x4){0.f, 0.f, 0.f, 0.f};
    float m_run = -1e30f, l_run = 0.f;
    const float scale = 0.08838834764831845f * LOG2E;
    for (int pp = 0; pp < 5; ++pp) {
        const int rowa = i0 + 32 * pp, rowb = rowa + 16;
        f32x4 sa, sb; attn_qk<LDSA_K>(lds, rowa, rowb, qf, lane, sa, sb);
        {
            const int rela = rowa + 4 * g - qi, la = nb * 128 + rowa + 4 * g - 64; float ba[4], bb[4];
#pragma unroll
            for (int j = 0; j < 4; ++j) { int ta = rela + j; ta = ta < 0 ? 0 : (ta > 128 ? 128 : ta); int tb = rela + 16 + j; tb = tb < 0 ? 0 : (tb > 128 ? 128 : tb); ba[j] = tab[ta]; bb[j] = tab[tb]; }
#pragma unroll
            for (int j = 0; j < 4; ++j) {
                const int ra = rela + j, rb = rela + 16 + j, l0 = la + j, l1 = la + 16 + j;
                const bool oka = ((unsigned)ra <= 128u) && ((unsigned)l0 < (unsigned)L), okb = ((unsigned)rb <= 128u) && ((unsigned)l1 < (unsigned)L);
                const float va = fmaf(sa[j], scale, ba[j]), vb = fmaf(sb[j], scale, bb[j]);
                sa[j] = oka ? va : -INFINITY; sb[j] = okb ? vb : -INFINITY;
            }
        }
        attn_pv<LDSA_V>(lds, rowa, rowb, sa, sb, O, m_run, l_run, lane);
    }
    l_run += __shfl_xor(l_run, 16); l_run += __shfl_xor(l_run, 32);
    if (g == 0) { f32x2 ml; ml.x = m_run * LN2; ml.y = l_run; *(f32x2*)(ML + ((size_t)(b * 8 + h) * SEQ + qpos) * 2) = ml; }
    const float inv = 1.0f / l_run;
    store_o_rows((bf16_t*)NUM + ((size_t)b * SEQ + qpos) * 1024 + h * 128, O, inv, g);
}
__device__ __forceinline__ void attn_a_phase(LAS unsigned char* lds, int first, int stride, int count, const bf16_t* Qb, const bf16_t* Kb, const bf16_t* Vb, const float* t5, float* NUM, float* ML) {
    int tid = threadIdx.x; asm volatile("" : "+v"(tid));
    if (count <= 0) return;
    if (tid < 256) { const int row = 256 + (tid >> 4), ch = tid & 15; const u32x4 z = (u32x4){0u, 0u, 0u, 0u};
        *(LAS u32x4*)(lds + LDSA_K + row * KSTR + ch * 16) = z; *(LAS u32x4*)(lds + LDSA_V + row * VSTR + ch * 16) = z; }
    u32x4 kv[8], vv[8];
    a_load(first, tid, Kb, Vb, kv, vv);
    for (int k = 0; k < count; ++k) {
        const int item = first + k * stride;
        a_store(lds, item, tid, t5, kv, vv);
        __syncthreads();
        bf16x8 qf[4];
        { const AItem a = a_decode(item); const int wid = __builtin_amdgcn_readfirstlane(tid >> 6), lane = tid & 63; const int qpos = (a.nb * 128 + 16 * wid + (lane & 15)) * a.d + a.r;
#pragma unroll
          for (int s = 0; s < 4; ++s) qf[s] = *(const bf16x8*)(Qb + (size_t)qpos * 1024 + a.h * 128 + s * 32 + (lane >> 4) * 8); }
        if (k + 1 < count) a_load(item + stride, tid, Kb, Vb, kv, vv);
        a_compute(lds, item, tid, qf, NUM, ML);
        __syncthreads();
    }
}

__device__ __forceinline__ void attn_a_merge(const float* NUM, const float* ML, bf16_t* MG, int first, int stride, int lo, int hi) {
    const bf16_t* NB = (const bf16_t*)NUM;
    for (int it = lo + first; it < hi; it += stride) {
        const int token = it >> 7, c8 = (it & 127) * 8, h = c8 >> 7;
        const f32x2 a = *(const f32x2*)(ML + ((size_t)(0 * 8 + h) * SEQ + token) * 2), b = *(const f32x2*)(ML + ((size_t)(1 * 8 + h) * SEQ + token) * 2), c = *(const f32x2*)(ML + ((size_t)(2 * 8 + h) * SEQ + token) * 2);
        const float M = fmaxf(a.x, fmaxf(b.x, c.x)); float wa = __expf(a.x - M) * a.y, wb = __expf(b.x - M) * b.y, wc = __expf(c.x - M) * c.y;
        const float inv = 1.0f / (wa + wb + wc); wa *= inv; wb *= inv; wc *= inv;
        const u32x4 na = *(const u32x4*)(NB + ((size_t)0 * SEQ + token) * 1024 + c8), nb = *(const u32x4*)(NB + ((size_t)1 * SEQ + token) * 1024 + c8), nc = *(const u32x4*)(NB + ((size_t)2 * SEQ + token) * 1024 + c8);
        u32x4 w;
#pragma unroll
        for (int e = 0; e < 4; ++e) { const float lo_ = bf_lo(na[e]) * wa + bf_lo(nb[e]) * wb + bf_lo(nc[e]) * wc, hi_ = bf_hi(na[e]) * wa + bf_hi(nb[e]) * wb + bf_hi(nc[e]) * wc; w[e] = cvt_pk_bf16(lo_, hi_); }
        *(u32x4*)(MG + (size_t)token * DM + c8) = w;
    }
}

__device__ __forceinline__ int c_rs0(int item) { const int r0 = 2 * (item >> 4); return (r0 - 4) < 0 ? 0 : ((r0 - 4) > 120 ? 120 : (r0 - 4)); }
__device__ __forceinline__ void c_load(int item, int ci, int tid, const bf16_t* Kb, const bf16_t* Vb, u32x4 (&kv)[6], u32x4 (&vv)[6]) {
    const int h = item & 15, rs0 = c_rs0(item);
#pragma unroll
    for (int it = 0; it < 6; ++it) {
        const int cid = tid + NTHR * it, row = cid >> 4, ch = cid & 15; const int kr = rs0 + 3 * ci + (row >> 6), kc = row & 63;
        if (kr < 128) { const size_t off = ((size_t)(kr * 64 + kc) * DM + h * 128 + ch * 8); kv[it] = *(const u32x4*)(Kb + off); vv[it] = *(const u32x4*)(Vb + off); }
        else { kv[it] = (u32x4){0u, 0u, 0u, 0u}; vv[it] = kv[it]; }
    }
}
__device__ __forceinline__ void c_store(LAS unsigned char* lds, int tid, const u32x4 (&kv)[6], const u32x4 (&vv)[6]) {
#pragma unroll
    for (int it = 0; it < 6; ++it) { const int cid = tid + NTHR * it, row = cid >> 4, ch = cid & 15;
        *(LAS u32x4*)(lds + LDSC_K + row * KSTR + ch * 16) = kv[it]; *(LAS u32x4*)(lds + LDSC_V + row * VSTR + ch * 16) = vv[it]; }
}
__device__ __forceinline__ void attn_c_phase(LAS unsigned char* lds, int first, int stride, const bf16_t* Qb, const bf16_t* Kb, const bf16_t* Vb, const float* rpb, bf16_t* MG,
                                             const float* w1s, bf16_t* w1d, const float* w2s, bf16_t* w2d, const float* g1) {
    int tid = threadIdx.x; asm volatile("" : "+v"(tid));
    if (first >= 1024) return;
    const int wid = __builtin_amdgcn_readfirstlane(tid >> 6), lane = tid & 63, fr = lane & 15, g = lane >> 4;
    LAS float* tab = (LAS float*)(lds + LDS_TAB);
    const int rsel = wid >> 2, ct = wid & 3;
    const int colbase = (ct == 0) ? 0 : ((ct == 1) ? 8 : ((ct == 2) ? 24 : 32));
    const int qc = 16 * ct + fr; const int cws = (qc - 8) < 0 ? 0 : ((qc - 8) > 48 ? 48 : (qc - 8));
    const float scale = 0.08838834764831845f * LOG2E;
    u32x4 kv[6], vv[6];
    c_load(first, 0, tid, Kb, Vb, kv, vv);
    bf16x8 qf[4]; f32x4 O[8]; float m_run = -1e30f, l_run = 0.f;
    for (int item = first; item < 1024; item += stride) {
        const int h = item & 15, r0 = 2 * (item >> 4), rs0 = c_rs0(item);
        const int qr = r0 + rsel, token = qr * 64 + qc;
        const int rws = (qr - 4) < 0 ? 0 : ((qr - 4) > 120 ? 120 : (qr - 4));
#pragma unroll
        for (int s = 0; s < 4; ++s) qf[s] = *(const bf16x8*)(Qb + (size_t)token * DM + h * 128 + s * 32 + g * 8);
#pragma unroll
        for (int cb = 0; cb < 8; ++cb) O[cb] = (f32x4){0.f, 0.f, 0.f, 0.f};
        m_run = -1e30f; l_run = 0.f;
        for (int ci = 0; ci < 3; ++ci) {
            c_store(lds, tid, kv, vv);
            if (ci == 0 && tid < 465) tab[tid] = rpb[h * 465 + tid] * LOG2E;
            __syncthreads();
            if (ci < 2) c_load(item, ci + 1, tid, Kb, Vb, kv, vv);
            else if (item + stride < 1024) c_load(item + stride, 0, tid, Kb, Vb, kv, vv);
            f32x4 cv[8]; const int ctile = item * 8 + wid;
            if (ci == 0) conv_issue(w1s, DFF, ctile, lane, cv); else if (ci == 1) conv_issue(w2s, DM, ctile, lane, cv);
            for (int lr = 0; lr < 3; ++lr) {
                const int kr = rs0 + 3 * ci + lr;
                if (kr < rws || kr >= rws + 8) continue;
                const int rowa = lr * 64 + colbase, rowb = rowa + 16;
                f32x4 sa, sb; attn_qk<LDSC_K>(lds, rowa, rowb, qf, lane, sa, sb);
                const int tb = (kr - qr + 7) * 31 + 15 - qc; const int kc0 = colbase + 4 * g; float ba[4], bb[4];
#pragma unroll
                for (int j = 0; j < 4; ++j) { int ta = tb + kc0 + j; ta = ta < 0 ? 0 : (ta > 464 ? 464 : ta); int t2 = tb + kc0 + 16 + j; t2 = t2 < 0 ? 0 : (t2 > 464 ? 464 : t2); ba[j] = tab[ta]; bb[j] = tab[t2]; }
#pragma unroll
                for (int j = 0; j < 4; ++j) {
                    const bool oka = (unsigned)(kc0 + j - cws) < 16u, okb = (unsigned)(kc0 + 16 + j - cws) < 16u;
                    const float va = fmaf(sa[j], scale, ba[j]), vb = fmaf(sb[j], scale, bb[j]);
                    sa[j] = oka ? va : -INFINITY; sb[j] = okb ? vb : -INFINITY;
                }
                attn_pv<LDSC_V>(lds, rowa, rowb, sa, sb, O, m_run, l_run, lane);
            }
            if (ci == 0) conv_finish(w1d, DM, DFF, ctile, lane, cv, g1); else if (ci == 1) conv_finish(w2d, DFF, DM, ctile, lane, cv, nullptr);
            __syncthreads();
        }
        l_run += __shfl_xor(l_run, 16); l_run += __shfl_xor(l_run, 32);
        const float inv = 1.0f / l_run;
        store_o_rows(MG + (size_t)token * DM + h * 128, O, inv, g);
    }
}

__device__ __forceinline__ void s5_gen(LAS unsigned char* lds, const Params& P, int j, int g) {
    const int tid = threadIdx.x;
    LAS f32x2* pw = (LAS f32x2*)lds;
    LAS f32x2* bb = (LAS f32x2*)(lds + 33792);
    LAS f32x2* cc = (LAS f32x2*)(lds + 33792 + 16384);
    LAS float* kern = (LAS float*)(lds + 33792 + 32768);
    const float* lam_re = P.in[4]; const float* lam_im = P.in[5]; const float* log_step = P.in[6];
    const float* b_re = P.in[7]; const float* b_im = P.in[8]; const float* c_re = P.in[9]; const float* c_im = P.in[10]; const float* dsk = P.in[11];
    for (int e = tid; e < 2 * 33 * 64; e += NTHR) {
        const int pp = e & 63, k = (e >> 6) % 33, dir = e / (33 * 64);
        const int idx = ((j * 2 + dir) * 64 + g) * 64 + pp;
        const float step = expf(log_step[(j * 2 + dir) * 64 + g]); const float lr = fminf(lam_re[idx], -1e-4f), li = lam_im[idx];
        const float rho = lr * step, th = li * step; const float mg = expf((float)k * rho); float sn, cs; sincosf((float)k * th, &sn, &cs);
        f32x2 v; v.x = mg * cs; v.y = mg * sn; pw[e] = v;
    }
    if (tid < 128) {
        const int dir = tid >> 6, pp = tid & 63; const int idx = ((j * 2 + dir) * 64 + g) * 64 + pp;
        const double step = exp((double)log_step[(j * 2 + dir) * 64 + g]); const double lr = fmin((double)lam_re[idx], -1e-4), li = (double)lam_im[idx];
        const double mg = exp(lr * step); const double abr = mg * cos(li * step), abi = mg * sin(li * step); const double den = lr * lr + li * li;
        const float zr = (float)(((abr - 1.0) * lr + abi * li) / den), zi = (float)((abi * lr - (abr - 1.0) * li) / den);
        for (int c = 0; c < 16; ++c) { const float br = b_re[((j * 64 + g) * 64 + pp) * 16 + c], bi = b_im[((j * 64 + g) * 64 + pp) * 16 + c];
            f32x2 v; v.x = zr * br - zi * bi; v.y = zr * bi + zi * br; bb[(dir * 64 + pp) * 16 + c] = v; }
        const double mg32 = exp(32.0 * lr * step); f32x2 a32; a32.x = (float)(mg32 * cos(32.0 * li * step)); a32.y = (float)(mg32 * sin(32.0 * li * step));
        *(f32x2*)(P.ws + WS_A32 + (size_t)idx * 8) = a32;
    }
    for (int e = tid; e < 2 * 16 * 64; e += NTHR) { const int dir = e >> 10, rem = e & 1023; const size_t gi = (size_t)((j * 2 + dir) * 64 + g) * 1024 + rem; f32x2 v; v.x = c_re[gi]; v.y = c_im[gi]; cc[e] = v; }
    __syncthreads();
    for (int e = tid; e < 1024; e += NTHR) {
        const int dir = e >> 9, tau = (e >> 4) & 31, co = e & 15; float acc16[16];
#pragma unroll
        for (int ci = 0; ci < 16; ++ci) acc16[ci] = 0.f;
        for (int pp = 0; pp < 64; ++pp) {
            const f32x2 w = pw[(dir * 33 + tau) * 64 + pp], c = cc[(dir * 16 + co) * 64 + pp];
            const float tr = c.x * w.x - c.y * w.y, ti = c.x * w.y + c.y * w.x;
            const LAS f32x4* bp = (const LAS f32x4*)(bb + (dir * 64 + pp) * 16);
#pragma unroll
            for (int q = 0; q < 8; ++q) { const f32x4 b2 = bp[q]; acc16[2 * q] += tr * b2[0] - ti * b2[1]; acc16[2 * q + 1] += tr * b2[2] - ti * b2[3]; }
        }
#pragma unroll
        for (int q = 0; q < 4; ++q) { f32x4 o; o[0] = acc16[4 * q]; o[1] = acc16[4 * q + 1]; o[2] = acc16[4 * q + 2]; o[3] = acc16[4 * q + 3]; *(LAS f32x4*)(kern + e * 16 + 4 * q) = o; }
    }
    __syncthreads();
    bf16_t* B3 = (bf16_t*)(P.ws + WS_B3 + (size_t)j * SZ_B3) + (size_t)g * 512 * 768;
    for (int ch = tid; ch < 512 * 96; ch += NTHR) {
        const int row = ch / 96, kc = (ch % 96) * 8, t = row >> 4, co = row & 15; float v[8];
        if (kc < 512) { const int s = kc >> 4, ci0 = kc & 15; f32x4 a0 = (f32x4){0.f, 0.f, 0.f, 0.f}, a1 = a0;
            if (s <= t) { const LAS f32x4* kp = (const LAS f32x4*)(kern + ((0 * 32 + (t - s)) * 16 + co) * 16 + ci0); a0 += kp[0]; a1 += kp[1]; }
            if (s >= t) { const LAS f32x4* kp = (const LAS f32x4*)(kern + ((1 * 32 + (s - t)) * 16 + co) * 16 + ci0); a0 += kp[0]; a1 += kp[1]; }
#pragma unroll
            for (int e = 0; e < 4; ++e) { v[e] = a0[e]; v[4 + e] = a1[e]; }
            if (s == t && (co >> 3) == (ci0 >> 3)) {
#pragma unroll
                for (int e = 0; e < 8; ++e) if (e == (co & 7)) v[e] += dsk[j * 1024 + 16 * g + co];
            } }
        else { const int kk = kc - 512, dir = kk >> 7, im = (kk >> 6) & 1, p0 = kk & 63; const int ex = (dir == 0) ? (t + 1) : (32 - t);
#pragma unroll
            for (int e = 0; e < 8; ++e) { const int pp = p0 + e; const f32x2 c = cc[(dir * 16 + co) * 64 + pp], w = pw[(dir * 33 + ex) * 64 + pp];
                v[e] = im ? -(c.x * w.y + c.y * w.x) : (c.x * w.x - c.y * w.y); } }
        u32x4 w; w.x = cvt_pk_bf16(v[0], v[1]); w.y = cvt_pk_bf16(v[2], v[3]); w.z = cvt_pk_bf16(v[4], v[5]); w.w = cvt_pk_bf16(v[6], v[7]);
        *(u32x4*)(B3 + (size_t)row * 768 + kc) = w;
    }
    bf16_t* B1 = (bf16_t*)(P.ws + WS_B1 + (size_t)j * SZ_B1) + (size_t)g * 256 * 512;
    for (int ch = tid; ch < 256 * 64; ch += NTHR) {
        const int row = ch >> 6, kc = (ch & 63) * 8, dir = row >> 7, im = (row >> 6) & 1, pp = row & 63, t = kc >> 4, c0 = kc & 15; const int ex = (dir == 0) ? (31 - t) : t;
        const f32x2 w = pw[(dir * 33 + ex) * 64 + pp]; float v[8];
#pragma unroll
        for (int e = 0; e < 8; ++e) { const f32x2 b = bb[(dir * 64 + pp) * 16 + c0 + e]; v[e] = im ? (w.x * b.y + w.y * b.x) : (w.x * b.x - w.y * b.y); }
        u32x4 wv; wv.x = cvt_pk_bf16(v[0], v[1]); wv.y = cvt_pk_bf16(v[2], v[3]); wv.z = cvt_pk_bf16(v[4], v[5]); wv.w = cvt_pk_bf16(v[6], v[7]);
        *(u32x4*)(B1 + (size_t)row * 512 + kc) = wv;
    }
    __syncthreads();
}

__device__ __forceinline__ void s5_carry(LAS unsigned char* lds, const Params& P, int j, int g, int dir) {
    int tid = threadIdx.x; asm volatile("" : "+v"(tid));
    const float* Z = (const float*)(P.ws + WS_Z); bf16_t* U2 = (bf16_t*)(P.ws + WS_U2);
    LAS float* zl = (LAS float*)lds;
#pragma unroll
    for (int it = 0; it < 16; ++it) { const int cid = tid + NTHR * it, n = cid >> 5, c4 = (cid & 31) * 4;
        *(LAS f32x4*)(zl + n * 128 + c4) = *(const f32x4*)(Z + (size_t)(g * 256 + n) * 256 + dir * 128 + c4); }
    __syncthreads();
    if (tid < 64) {
        const int pp = tid; const int idx = ((j * 2 + dir) * 64 + g) * 64 + pp;
        const f32x2 a32 = *(const f32x2*)(P.ws + WS_A32 + (size_t)idx * 8); const float ar = a32.x, ai = a32.y;
        float cr = 0.f, cim = 0.f;
        bf16_t* up = U2 + (size_t)g * 256 * 768 + 512 + dir * 128 + pp;
        for (int s = 0; s < 256; ++s) {
            const int n = dir ? (255 - s) : s;
            up[(size_t)n * 768] = (bf16_t)(cvt_pk_bf16(cr, 0.f) & 0xffffu); up[(size_t)n * 768 + 64] = (bf16_t)(cvt_pk_bf16(cim, 0.f) & 0xffffu);
            const float zr = zl[n * 128 + pp], zi = zl[n * 128 + 64 + pp];
            const float nr = ar * cr - ai * cim + zr, ni = ar * cim + ai * cr + zi; cr = nr; cim = ni;
        }
    }
    __syncthreads();
}

__device__ __forceinline__ void s5_carry2(const Params& P, int j, int g) {
    int tid = threadIdx.x; asm volatile("" : "+v"(tid));
    const int wid = __builtin_amdgcn_readfirstlane(tid >> 6), pp = tid & 63;
    if (wid < 2) {
        const int dir = wid; const int idx = ((j * 2 + dir) * 64 + g) * 64 + pp;
        const f32x2 a32 = *(const f32x2*)(P.ws + WS_A32 + (size_t)idx * 8); const float ar = a32.x, ai = a32.y;
        const float* zp = (const float*)(P.ws + WS_Z) + (size_t)(g * 256) * 256 + dir * 128 + pp;
        bf16_t* up = (bf16_t*)(P.ws + WS_U2) + (size_t)g * 256 * 768 + 512 + dir * 128 + pp;
        float cr = 0.f, cim = 0.f; float zr[8], zi[8], nzr[8], nzi[8];
#pragma unroll
        for (int u = 0; u < 8; ++u) { const int n = dir ? (255 - u) : u; zr[u] = zp[(size_t)n * 256]; zi[u] = zp[(size_t)n * 256 + 64]; }
        for (int s0 = 0; s0 < 256; s0 += 8) {
            if (s0 + 8 < 256) {
#pragma unroll
                for (int u = 0; u < 8; ++u) { const int n = dir ? (255 - (s0 + 8 + u)) : (s0 + 8 + u); nzr[u] = zp[(size_t)n * 256]; nzi[u] = zp[(size_t)n * 256 + 64]; }
            }
#pragma unroll
            for (int u = 0; u < 8; ++u) { const int n = dir ? (255 - (s0 + u)) : (s0 + u);
                up[(size_t)n * 768] = (bf16_t)(cvt_pk_bf16(cr, 0.f) & 0xffffu); up[(size_t)n * 768 + 64] = (bf16_t)(cvt_pk_bf16(cim, 0.f) & 0xffffu);
                const float nr = ar * cr - ai * cim + zr[u], ni = ar * cim + ai * cr + zi[u]; cr = nr; cim = ni; }
#pragma unroll
            for (int u = 0; u < 8; ++u) { zr[u] = nzr[u]; zi[u] = nzi[u]; }
        }
    }
    __syncthreads();
}

__device__ __forceinline__ void conv_tile(const float* src, bf16_t* dst, int K, int N, int tile, int lane, const float* gk) {
    const int tn = N >> 5; const int k0 = (tile / tn) * 64, n0 = (tile % tn) * 32; const int kg = lane & 7, jn = lane >> 3;
    f32x4 v[8]; const float* sp = src + (size_t)(k0 + 8 * kg) * N + n0 + 4 * jn;
#pragma unroll
    for (int r = 0; r < 8; ++r) v[r] = *(const f32x4*)(sp + (size_t)r * N);
    if (gk) { const f32x4 g0 = *(const f32x4*)(gk + k0 + 8 * kg), g1 = *(const f32x4*)(gk + k0 + 8 * kg + 4);
#pragma unroll
        for (int r = 0; r < 4; ++r) { v[r] *= g0[r]; v[4 + r] *= g1[r]; } }
#pragma unroll
    for (int i = 0; i < 4; ++i) { u32x4 w; w.x = cvt_pk_bf16(v[0][i], v[1][i]); w.y = cvt_pk_bf16(v[2][i], v[3][i]); w.z = cvt_pk_bf16(v[4][i], v[5][i]); w.w = cvt_pk_bf16(v[6][i], v[7][i]);
        *(u32x4*)(dst + (size_t)(n0 + 4 * jn + i) * K + k0 + 8 * kg) = w; }
}
constexpr int T_WIN = 4096, T_WOUT = 2048, T_GLU = 512, T_QKV = 6144, T_W1 = 8192, T_W2 = 8192;
constexpr int T_EVEN = T_WIN + T_WOUT + T_GLU + T_W1 + T_W2, T_ODD = T_QKV + T_WOUT + T_W1 + T_W2, T_PAIR = T_EVEN + T_ODD, T_ALL = 2 * T_PAIR;
__device__ __forceinline__ void conv_dispatch(const Params& P, int tile, int lane) {
    const int j = tile / T_PAIR; int rem = tile % T_PAIR; unsigned char* ws = P.ws;
    if (rem < T_EVEN) { const int i = 2 * j;
        if (rem < T_WIN) { conv_tile(P.in[2] + (size_t)j * 2048 * 4096, (bf16_t*)(ws + WS_WIN + j * SZ_WIN), 2048, 4096, rem, lane, P.in[16] + (size_t)i * DM); return; } rem -= T_WIN;
        if (rem < T_WOUT) { conv_tile(P.in[3] + (size_t)j * 2048 * 2048, (bf16_t*)(ws + WS_WOUT + j * SZ_WOUT), 2048, 2048, rem, lane, nullptr); return; } rem -= T_WOUT;
        if (rem < T_GLU) { conv_tile(P.in[12] + (size_t)j * 1024 * 1024, (bf16_t*)(ws + WS_GLU + j * SZ_GLU), 1024, 1024, rem, lane, nullptr); return; } rem -= T_GLU;
        if (rem < T_W1) { conv_tile(P.in[18] + (size_t)i * 2048 * 8192, (bf16_t*)(ws + WS_W1 + i * SZ_W1), 2048, 8192, rem, lane, P.in[17] + (size_t)i * DM); return; } rem -= T_W1;
        conv_tile(P.in[19] + (size_t)i * 8192 * 2048, (bf16_t*)(ws + WS_W2 + i * SZ_W2), 8192, 2048, rem, lane, nullptr);
    } else { rem -= T_EVEN; const int i = 2 * j + 1;
        if (rem < T_QKV) { conv_tile(P.in[13] + (size_t)j * 2048 * 6144, (bf16_t*)(ws + WS_QKV + j * SZ_QKV), 2048, 6144, rem, lane, P.in[16] + (size_t)i * DM); return; } rem -= T_QKV;
        if (rem < T_WOUT) { conv_tile(P.in[14] + (size_t)j * 2048 * 2048, (bf16_t*)(ws + WS_COUT + j * SZ_WOUT), 2048, 2048, rem, lane, nullptr); return; } rem -= T_WOUT;
        if (rem < T_W1) { conv_tile(P.in[18] + (size_t)i * 2048 * 8192, (bf16_t*)(ws + WS_W1 + i * SZ_W1), 2048, 8192, rem, lane, P.in[17] + (size_t)i * DM); return; } rem -= T_W1;
        conv_tile(P.in[19] + (size_t)i * 8192 * 2048, (bf16_t*)(ws + WS_W2 + i * SZ_W2), 8192, 2048, rem, lane, nullptr);
    }
}

#define XB_TMO      128
#define XB_XCNT(j)  (256  + 64 * (j))
#define XB_XSUB(j)  (1280 + 64 * (j))
#define XB_XGEN(j)  (2304 + 64 * (j))
#define XB_TOP      3328
#define XB_TOPGEN   3392
#define XCD_BAR_WORDS 3456
#define XB_SPIN_CAP (1u << 18)
__device__ __forceinline__ unsigned xb_ld(unsigned* p)              { return __hip_atomic_load(p, __ATOMIC_RELAXED, __HIP_MEMORY_SCOPE_AGENT); }
__device__ __forceinline__ unsigned xb_add(unsigned* p, unsigned v) { return __hip_atomic_fetch_add(p, v, __ATOMIC_RELAXED, __HIP_MEMORY_SCOPE_AGENT); }
__device__ __forceinline__ unsigned xb_xcc_id() { return (unsigned)__builtin_amdgcn_s_getreg((3 << 11) | 20) & 0xFu; }
#define XB_SPIN(cond, bar) do { unsigned _sp = 0; while (cond) { __builtin_amdgcn_s_sleep(1); \
    if ((++_sp & 255u) == 0u) { if (xb_ld(&(bar)[XB_TMO])) break; if (_sp > XB_SPIN_CAP) { atomicAdd(&(bar)[XB_TMO], 1u); break; } } } } while (0)
struct XcdBarrier { unsigned* bar; unsigned x; volatile LAS unsigned* st; };
__device__ __forceinline__ XcdBarrier xcd_barrier_post(unsigned* bar, volatile LAS unsigned* st) {
    XcdBarrier b; b.bar = bar; b.x = xb_xcc_id(); b.st = st;
    if (threadIdx.x == 0) (void)xb_add(&bar[XB_XCNT(b.x)], 1u);
    return b;
}
__device__ __forceinline__ void xcd_barrier_complete(unsigned* bar, unsigned x, unsigned& nloc, unsigned& nx) {
    const unsigned G = gridDim.x * gridDim.y * gridDim.z;
    unsigned sum, cnt, mine, sp = 0u;
    for (;;) {
        sum = 0u; cnt = 0u; mine = 0u;
#pragma unroll
        for (unsigned j = 0; j < 16; ++j) { const unsigned c = xb_ld(&bar[XB_XCNT(j)]); sum += c; cnt += (c > 0u) ? 1u : 0u; mine = (j == x) ? c : mine; }
        if (sum == G) break;
        __builtin_amdgcn_s_sleep(1);
        if ((++sp & 255u) == 0u) { if (xb_ld(&bar[XB_TMO])) break; if (sp > XB_SPIN_CAP) { atomicAdd(&bar[XB_TMO], 1u); break; } }
    }
    nloc = mine > 0u ? mine : 1u; nx = cnt > 0u ? cnt : 1u;
}
__device__ __forceinline__ void xcd_barrier(const XcdBarrier& b) {
    asm volatile("s_waitcnt vmcnt(0)" ::: "memory");
    __syncthreads();
    if (threadIdx.x == 0) {
        unsigned* bar = b.bar;
        __builtin_amdgcn_s_waitcnt(0);
        unsigned nloc = b.st[0], nx = b.st[1];
        if (nloc == 0u) { xcd_barrier_complete(bar, b.x, nloc, nx); b.st[0] = nloc; b.st[1] = nx; }
        const unsigned old = xb_add(&bar[XB_XSUB(b.x)], 1u);
        const unsigned gen = old / nloc;
        if (old + 1u == (gen + 1u) * nloc) {
            __builtin_amdgcn_fence(__ATOMIC_RELEASE, "agent");
            asm volatile("s_waitcnt vmcnt(0)" ::: "memory");
            const unsigned og = xb_add(&bar[XB_TOP], 1u);
            const unsigned tg = og / nx;
            if (og + 1u == (tg + 1u) * nx) xb_add(&bar[XB_TOPGEN], 1u);
            else XB_SPIN(xb_ld(&bar[XB_TOPGEN]) == tg, bar);
            __builtin_amdgcn_fence(__ATOMIC_ACQUIRE, "agent");
            xb_add(&bar[XB_XGEN(b.x)], 1u);
            asm volatile("s_waitcnt vmcnt(0)" ::: "memory");
        } else {
            XB_SPIN(xb_ld(&bar[XB_XGEN(b.x)]) == gen, bar);
            __builtin_amdgcn_fence(__ATOMIC_ACQUIRE, "agent");
            asm volatile("s_waitcnt vmcnt(0)" ::: "memory");
        }
    }
    __syncthreads();
}
constexpr int MERGE_ITEMS = SEQ * 128, MERGE_SPLIT = (MERGE_ITEMS / 16) * 7;
constexpr int LDS_XB = LDS_BYTES - 16;

__global__ void __launch_bounds__(NTHR) hybrid_encoder_fwd(Params P) {
    extern __shared__ __attribute__((aligned(16))) unsigned char lds_raw[];
    LAS unsigned char* lds = (LAS unsigned char*)lds_raw;
    cg::grid_group grid = cg::this_grid();
    if (threadIdx.x == 0) { *(volatile LAS unsigned*)(lds + LDS_XB) = 0u; *(volatile LAS unsigned*)(lds + LDS_XB + 4) = 0u; }
    __syncthreads();
    const XcdBarrier xb = xcd_barrier_post((unsigned*)P.ws, (volatile LAS unsigned*)(lds + LDS_XB));
    const int tid = threadIdx.x, lane = tid & 63, wid = __builtin_amdgcn_readfirstlane(tid >> 6);
    const int bid = blockIdx.x, G = gridDim.x;
    unsigned char* ws = P.ws;
    bf16_t* XG = (bf16_t*)(ws + WS_XG);
    bf16_t* Qb = (bf16_t*)(ws + WS_Q); bf16_t* Kb = (bf16_t*)(ws + WS_K); bf16_t* Vb = (bf16_t*)(ws + WS_V);
    bf16_t* U2 = (bf16_t*)(ws + WS_U2); float* Z = (float*)(ws + WS_Z); bf16_t* Y = (bf16_t*)(ws + WS_Y); bf16_t* MG = (bf16_t*)(ws + WS_MG);
    bf16_t* H = (bf16_t*)(ws + WS_H); float* NUM = (float*)(ws + WS_NUM); float* ML = (float*)(ws + WS_ML); float* SSQ = (float*)(ws + WS_SSQ);
#define GSYNC0() do { asm volatile("s_waitcnt vmcnt(0) lgkmcnt(0)" ::: "memory"); grid.sync(); } while (0)
#define GSYNC() xcd_barrier(xb)

    {
        {
            const float* x = P.in[0];
            for (int row = bid * 8 + wid; row < SEQ; row += G * 8) {
                float ss = 0.f;
#pragma unroll
                for (int i = 0; i < 8; ++i) { const int c = lane * 4 + 256 * i; const f32x4 v = *(const f32x4*)(x + (size_t)row * DM + c);
                    u32x2 w; w.x = cvt_pk_bf16(v[0], v[1]); w.y = cvt_pk_bf16(v[2], v[3]);
                    const float r0 = bf_lo(w.x), r1 = bf_hi(w.x), r2 = bf_lo(w.y), r3 = bf_hi(w.y); ss += (r0 * r0 + r1 * r1) + (r2 * r2 + r3 * r3);
                    *(u32x2*)(XG + (size_t)row * DM + c) = w; }
                ss += __shfl_xor(ss, 32);
                if (lane < 32) SSQ[(size_t)row * 32 + lane] = ss;
            }
        }
        for (int it = bid; it < 128; it += G) { s5_gen(lds, P, it >> 6, it & 63);
        }
        {
            constexpr int PB_PAIR = (T_PAIR - T_W1 - T_W2) / 4, NBATCH = 2 * PB_PAIR, NB1 = 6144;
#define PREP_TILE(bt) (((bt) / PB_PAIR) * T_PAIR + ((bt) % PB_PAIR) * 4)
            if (bid >= 128) for (int bt = (bid - 128) * 8 + wid; bt < NB1; bt += (G - 128) * 8) {
#pragma unroll 1
                for (int q = 0; q < 4; ++q) conv_dispatch(P, PREP_TILE(bt) + q, lane); }
            for (int bt = NB1 + bid * 8 + wid; bt < NBATCH; bt += G * 8) {
#pragma unroll 1
                for (int q = 0; q < 4; ++q) conv_dispatch(P, PREP_TILE(bt) + q, lane); }
#undef PREP_TILE
        }
    }
    GSYNC0();

    for (int layer = 0; layer < 4; ++layer) {
        const int j = layer >> 1; const bool odd = layer & 1;
        const float* ssq_mix = SSQ + (size_t)(2 * layer) * SEQ * 32; float* ssq_mlp = SSQ + (size_t)(2 * layer + 1) * SEQ * 32; float* ssq_nxt = SSQ + (size_t)(2 * layer + 2) * SEQ * 32;
        {
            Gemm gm; gm.A = XG; gm.Bt = odd ? (const bf16_t*)(ws + WS_QKV + j * SZ_QKV) : (const bf16_t*)(ws + WS_WIN + j * SZ_WIN); gm.lda = DM; gm.ldb = DM; gm.K = DM;
            StaticOrder S; S.init(SEQ, odd ? 6144 : 4096, G, bid);
            EpiIn E; E.Q = Qb; E.K = Kb; E.V = Vb; E.U2 = U2; E.ssq = ssq_mix; E.shift = odd ? 11 : 10; E.ldq = odd ? 2048 : 1024;
            gemm_phase<EpiIn, StaticOrder>(lds, gm, S, E);
        }
        GSYNC();
        if (!odd) {
            {
                Gemm gm; gm.A = U2; gm.Bt = (const bf16_t*)(ws + WS_B1 + j * SZ_B1); gm.lda = 768; gm.ldb = 512; gm.K = 512;
                ListOrder S; S.total = 64; S.G = 64; S.c = bid; S.mode = 0;
                EpiP1 E; E.Z = Z;
                gemm_phase<EpiP1, ListOrder>(lds, gm, S, E);
                if (bid < 64) {
                    asm volatile("s_waitcnt vmcnt(0)" ::: "memory"); __syncthreads();
                    __builtin_amdgcn_fence(__ATOMIC_ACQUIRE, "agent"); asm volatile("s_waitcnt vmcnt(0)" ::: "memory");
                    s5_carry2(P, j, bid);
                    asm volatile("s_waitcnt vmcnt(0)" ::: "memory"); __syncthreads();
                    __builtin_amdgcn_fence(__ATOMIC_ACQUIRE, "agent"); asm volatile("s_waitcnt vmcnt(0)" ::: "memory"); __syncthreads();
                    Gemm g3; g3.A = U2; g3.Bt = (const bf16_t*)(ws + WS_B3 + j * SZ_B3); g3.lda = 768; g3.ldb = 768; g3.K = 768;
                    ListOrder S3; S3.total = 128; S3.G = 64; S3.c = bid; S3.mode = 2;
                    EpiP3 E3; E3.Y = Y;
                    gemm_phase<EpiP3, ListOrder>(lds, g3, S3, E3);
                } else {
                    attn_a_phase(lds, bid - 64, 192, 8, Qb, Kb, Vb, P.in[1], NUM, ML);
                }
            }
            GSYNC();
            {
                Gemm gm; gm.A = Y; gm.Bt = (const bf16_t*)(ws + WS_GLU + j * SZ_GLU); gm.lda = 1024; gm.ldb = 1024; gm.K = 1024;
                StaticOrder S; S.init(SEQ, 1024, G, bid);
                EpiGlu E; E.Y = Y; E.MG = MG;
                gemm_phase<EpiGlu, StaticOrder>(lds, gm, S, E);
                if (bid >= 128) attn_a_merge(NUM, ML, MG, (bid - 128) * NTHR + tid, 128 * NTHR, 0, MERGE_ITEMS);
            }
            GSYNC();
        } else {
            attn_c_phase(lds, bid, G, Qb, Kb, Vb, P.in[15] + (size_t)j * 16 * 465, MG,
                         P.in[18] + (size_t)layer * 2048 * 8192, (bf16_t*)(ws + WS_W1 + layer * SZ_W1), P.in[19] + (size_t)layer * 8192 * 2048, (bf16_t*)(ws + WS_W2 + layer * SZ_W2), P.in[17] + (size_t)layer * DM);
            GSYNC();
        }
        {
            Gemm gm; gm.A = MG; gm.Bt = odd ? (const bf16_t*)(ws + WS_COUT + j * SZ_WOUT) : (const bf16_t*)(ws + WS_WOUT + j * SZ_WOUT); gm.lda = DM; gm.ldb = DM; gm.K = DM;
            StaticOrder S; S.init(SEQ, DM, G, bid);
            EpiRes E; E.XB = XG; E.ssq_next = ssq_mlp;
            gemm_phase<EpiRes, StaticOrder>(lds, gm, S, E);
        }
        GSYNC();
        {
            Gemm gm; gm.A = XG; gm.Bt = (const bf16_t*)(ws + WS_W1 + layer * SZ_W1); gm.lda = DM; gm.ldb = DM; gm.K = DM;
            StaticOrder S; S.init(SEQ, DFF, G, bid);
            EpiH E; E.H = H; E.ssq = ssq_mlp;
            gemm_phase<EpiH, StaticOrder>(lds, gm, S, E);
        }
        GSYNC();
        {
            Gemm gm; gm.A = H; gm.Bt = (const bf16_t*)(ws + WS_W2 + layer * SZ_W2); gm.lda = DFF; gm.ldb = DFF; gm.K = DFF;
            StaticOrder S; S.init(SEQ, DM, G, bid);
            EpiRes E; E.XB = XG; E.ssq_next = ssq_nxt;
            gemm_phase<EpiRes, StaticOrder>(lds, gm, S, E);
        }
        GSYNC();
    }
    {
        const float* ssq = SSQ + (size_t)8 * SEQ * 32; const float* gf = P.in[20];
        for (int row = bid * 8 + wid; row < SEQ; row += G * 8) {
            const float rs = row_rstd(ssq, row);
#pragma unroll
            for (int i = 0; i < 8; ++i) { const int c = lane * 4 + 256 * i;
                const u32x2 xw = *(const u32x2*)(XG + (size_t)row * DM + c); const f32x4 gv = *(const f32x4*)(gf + c);
                f32x4 v; v[0] = bf_lo(xw.x); v[1] = bf_hi(xw.x); v[2] = bf_lo(xw.y); v[3] = bf_hi(xw.y);
                *(f32x4*)(P.out + (size_t)row * DM + c) = v * rs * gv; }
        }
    }
}

extern "C" void kernel_launch(void* const* d_in, const int* in_sizes, int n_in, void* d_out, int out_size, void* d_ws, size_t ws_size, hipStream_t stream) {
    static int grid = 0;
    if (grid == 0) {
        if (n_in != 21 || ws_size < WS_END) { fprintf(stderr, "kernel_launch: need 21 inputs and %zu bytes of workspace (got %d, %zu)\n", (size_t)WS_END, n_in, ws_size); grid = -1; return; }
        int dev = 0, cus = 0, per_cu = 0;
        hipGetDevice(&dev); hipDeviceGetAttribute(&cus, hipDeviceAttributeMultiprocessorCount, dev);
        if (hipFuncSetAttribute((const void*)hybrid_encoder_fwd, hipFuncAttributeMaxDynamicSharedMemorySize, LDS_BYTES) != hipSuccess) { fprintf(stderr, "kernel_launch: hipFuncSetAttribute failed\n"); grid = -1; return; }
        if (hipOccupancyMaxActiveBlocksPerMultiprocessor(&per_cu, (const void*)hybrid_encoder_fwd, NTHR, LDS_BYTES) != hipSuccess || per_cu < 1) { fprintf(stderr, "kernel_launch: occupancy query says %d blocks/CU\n", per_cu); per_cu = 1; }
        (void)hipGetLastError();
        grid = cus;
    }
    if (grid < 0) return;
    hipMemsetAsync((char*)d_ws + WS_CTRL, 0, 16384, stream);
    Params p{};
    for (int i = 0; i < 21; ++i) p.in[i] = (const float*)d_in[i];
    p.out = (float*)d_out; p.ws = (unsigned char*)d_ws; p.coop = 1; p.pad = 0;
    void* args[] = {&p};
    hipError_t e = hipLaunchCooperativeKernel((const void*)hybrid_encoder_fwd, dim3(grid), dim3(NTHR), args, LDS_BYTES, stream);
    if (e != hipSuccess) fprintf(stderr, "cooperative launch failed: %s (grid %d)\n", hipGetErrorString(e), grid);
}
```

```cpp
#include <hip/hip_runtime.h>
#include <hip/hip_cooperative_groups.h>
#include <cstdio>
namespace cg = cooperative_groups;

#define LAS __attribute__((address_space(3)))
typedef unsigned short bf16_t;
typedef short bf16x8 __attribute__((ext_vector_type(8)));
typedef short s16x4 __attribute__((ext_vector_type(4)));
typedef float f32x4 __attribute__((ext_vector_type(4)));
typedef float f32x2 __attribute__((ext_vector_type(2)));
typedef unsigned u32x4 __attribute__((ext_vector_type(4)));
typedef unsigned u32x2 __attribute__((ext_vector_type(2)));

constexpr int SEQ = 8192, DM = 2048, DFF = 8192;
constexpr float RMS_EPS = 1e-6f;
constexpr int NTHR = 512;

constexpr size_t SZ_WIN = (size_t)4096 * 2048 * 2, SZ_WOUT = (size_t)2048 * 2048 * 2, SZ_GLU = (size_t)1024 * 1024 * 2;
constexpr size_t SZ_QKV = (size_t)6144 * 2048 * 2, SZ_W1 = (size_t)8192 * 2048 * 2, SZ_W2 = SZ_W1;
constexpr size_t SZ_B3 = (size_t)64 * 512 * 768 * 2, SZ_B1 = (size_t)64 * 256 * 512 * 2;
constexpr size_t WS_CTRL = 0;
constexpr size_t WS_WIN = 16384;
constexpr size_t WS_WOUT = WS_WIN + 2 * SZ_WIN;
constexpr size_t WS_GLU = WS_WOUT + 2 * SZ_WOUT;
constexpr size_t WS_QKV = WS_GLU + 2 * SZ_GLU;
constexpr size_t WS_COUT = WS_QKV + 2 * SZ_QKV;
constexpr size_t WS_W1 = WS_COUT + 2 * SZ_WOUT;
constexpr size_t WS_W2 = WS_W1 + 4 * SZ_W1;
constexpr size_t WS_B3 = WS_W2 + 4 * SZ_W2;
constexpr size_t WS_B1 = WS_B3 + 2 * SZ_B3;
constexpr size_t WS_X = WS_B1 + 2 * SZ_B1;
constexpr size_t WS_XG = WS_X + (size_t)SEQ * DM * 4;
constexpr size_t WS_Q = WS_XG + (size_t)SEQ * DM * 2;
constexpr size_t WS_K = WS_Q + (size_t)SEQ * DM * 2;
constexpr size_t WS_V = WS_K + (size_t)SEQ * DM * 2;
constexpr size_t WS_U2 = WS_V + (size_t)SEQ * DM * 2;
constexpr size_t WS_Z = WS_U2 + (size_t)64 * 256 * 768 * 2;
constexpr size_t WS_Y = WS_Z + (size_t)64 * 256 * 256 * 4;
constexpr size_t WS_MG = WS_Y + (size_t)SEQ * 1024 * 2;
constexpr size_t WS_H = WS_MG + (size_t)SEQ * DM * 2;
constexpr size_t WS_NUM = WS_H;
constexpr size_t WS_ML = WS_H + (size_t)SEQ * DFF * 2;
constexpr size_t WS_SSQ = WS_ML + (size_t)3 * 8 * SEQ * 8;
constexpr size_t WS_A32 = WS_SSQ + (size_t)9 * SEQ * 32 * 4;
constexpr size_t WS_END = WS_A32 + (size_t)2 * 2 * 64 * 64 * 8;

struct Params { const float* in[21]; float* out; unsigned char* ws; int coop; int pad; };

__device__ __forceinline__ unsigned cvt_pk_bf16(float lo, float hi) { unsigned r; asm volatile("v_cvt_pk_bf16_f32 %0, %1, %2" : "=v"(r) : "v"(lo), "v"(hi)); return r; }
__device__ __forceinline__ unsigned cvt_pk_bf16_t(float lo, float hi) { unsigned r; asm volatile("s_nop 1\n\tv_cvt_pk_bf16_f32 %0, %1, %2" : "=v"(r) : "v"(lo), "v"(hi)); return r; }
__device__ __forceinline__ unsigned cvt_pk_sw(float lo, float hi) { unsigned a = __float_as_uint(lo), b = __float_as_uint(hi); a += 0x7fffu + ((a >> 16) & 1u); b += 0x7fffu + ((b >> 16) & 1u); return (a >> 16) | (b & 0xffff0000u); }
__device__ __forceinline__ float bf_lo(unsigned w) { return __uint_as_float(w << 16); }
__device__ __forceinline__ float bf_hi(unsigned w) { return __uint_as_float(w & 0xffff0000u); }

__device__ __forceinline__ float row_rstd(const float* ssqp, int row) {
    const f32x4* p = (const f32x4*)(ssqp + (size_t)row * 32); f32x4 a = p[0];
#pragma unroll
    for (int i = 1; i < 8; ++i) a += p[i];
    return rsqrtf(((a[0] + a[1]) + (a[2] + a[3])) * (1.0f / DM) + RMS_EPS);
}
constexpr int BM = 256, BK = 64, HALF = 128, HTB = HALF * BK * 2, STAGE_BYTES = 8 * HTB, NXCD = 8, WGM = 8;
__device__ __forceinline__ int lds_byte(int r, int c) { const int st = (r >> 4) * 2 + (c >> 5), rr = r & 15, cc = c & 31, ob = rr * 64 + cc * 2; return st * 1024 + (ob ^ (((ob >> 9) & 1) << 5)); }
__device__ __forceinline__ void stage_rc(int b, int& R, int& C) { const int st = b / 1024, sb = b % 1024, swz = sb ^ (((sb >> 9) & 1) << 5); R = (st >> 1) * 16 + swz / 64; C = (st & 1) * 32 + (swz % 64) / 2; }
__device__ __forceinline__ int perm32(int rho) { const int n = rho >> 4, i = rho & 15; return 8 * (i >> 2) + 4 * n + (i & 3); }

struct Unit { int pm, pn; };
struct Gemm { const bf16_t* A; const bf16_t* Bt; int lda, ldb, K; };

struct StaticOrder {
    int nM, nN, nwg, G, c;
    __device__ void init(int M, int N, int G_, int c_) { nM = M / BM; nN = N / BM; nwg = nM * nN; G = G_; c = c_; }
    __device__ bool next(int i, Unit& u) const {
        const long L = (long)i * G + c; if (L >= nwg) return false;
        int wgid = (int)L; { const int q = nwg / NXCD, r = nwg % NXCD, xcd = wgid % NXCD, off = wgid / NXCD; wgid = (xcd < r ? xcd * (q + 1) : r * (q + 1) + (xcd - r) * q) + off; }
        const int nig = WGM * nN, gid = wgid / nig, fm = gid * WGM, gsz = (nM - fm) < WGM ? (nM - fm) : WGM;
        u.pm = fm + ((wgid % nig) % gsz); u.pn = (wgid % nig) / gsz; return true;
    }
};
struct ListOrder {
    int total, G, c, mode;
    __device__ bool next(int i, Unit& u) const {
        if (mode == 2) { if (c >= G || i >= 2) return false; u.pm = c; u.pn = 2 * c + i; return true; }
        const int L = i * G + c; if (c >= G || L >= total) return false; if (mode == 0) { u.pm = L; u.pn = L; } else { u.pm = L >> 1; u.pn = L; } return true; }
};


struct EpiIn {
    static constexpr bool PERM = true, NEEDS_RSTD = true;
    bf16_t* Q; bf16_t* K; bf16_t* V; bf16_t* U2; const float* ssq; int shift, ldq;
    __device__ __forceinline__ void operator()(const f32x4 (&acc)[2][2][4][2], const Unit& u, int ui, const LAS float* rtab, int wr, int wc, int fr, int fq) const {
        const int row0 = u.pm * BM + wr * 64 + fr; const int colt = u.pn * BM; const int t = colt >> shift; const int lc0 = (colt & ((1 << shift) - 1)) + wc * 32 + 8 * fq;
        bf16_t* base = (t == 0) ? Q : ((t == 1) ? K : V);
#pragma unroll
        for (int ai = 0; ai < 2; ++ai)
#pragma unroll
            for (int m = 0; m < 4; ++m) {
                const int row = row0 + ai * HALF + m * 16; const float rs = rtab[ui * 256 + wr * 64 + fr + ai * HALF + m * 16];
#pragma unroll
                for (int bj = 0; bj < 2; ++bj) {
                    const int lc = lc0 + bj * HALF; const f32x4 v0 = acc[ai][bj][m][0] * rs, v1 = acc[ai][bj][m][1] * rs;
                    u32x4 w; w.x = cvt_pk_bf16(v0[0], v0[1]); w.y = cvt_pk_bf16(v0[2], v0[3]); w.z = cvt_pk_bf16(v1[0], v1[1]); w.w = cvt_pk_bf16(v1[2], v1[3]);
                    if (t < 3) *(u32x4*)(base + (size_t)row * ldq + lc) = w;
                    else { const int g = lc >> 4, c = lc & 15, n = row >> 5, tt = row & 31; *(u32x4*)(U2 + ((size_t)(g * 256 + n) * 768 + tt * 16 + c)) = w; }
                }
            }
    }
};
struct EpiRes {
    static constexpr bool PERM = true, NEEDS_RSTD = false;
    bf16_t* XB; float* ssq_next;
    __device__ __forceinline__ void operator()(const f32x4 (&acc)[2][2][4][2], const Unit& u, int ui, const LAS float* rtab, int wr, int wc, int fr, int fq) const {
        const int row0 = u.pm * BM + wr * 64 + fr, col0 = u.pn * BM + wc * 32 + 8 * fq;
#pragma unroll
        for (int ai = 0; ai < 2; ++ai) {
            u32x4 xv[4][2];
#pragma unroll
            for (int m = 0; m < 4; ++m)
#pragma unroll
                for (int bj = 0; bj < 2; ++bj) xv[m][bj] = *(const u32x4*)(XB + (size_t)(row0 + ai * HALF + m * 16) * DM + col0 + bj * HALF);
#pragma unroll
            for (int m = 0; m < 4; ++m) { const int row = row0 + ai * HALF + m * 16; float ss = 0.f;
#pragma unroll
                for (int bj = 0; bj < 2; ++bj) {
                    const f32x4 a0 = acc[ai][bj][m][0], a1 = acc[ai][bj][m][1]; const u32x4 xo = xv[m][bj]; u32x4 w;
                    w.x = cvt_pk_bf16(bf_lo(xo.x) + a0[0], bf_hi(xo.x) + a0[1]); w.y = cvt_pk_bf16(bf_lo(xo.y) + a0[2], bf_hi(xo.y) + a0[3]);
                    w.z = cvt_pk_bf16(bf_lo(xo.z) + a1[0], bf_hi(xo.z) + a1[1]); w.w = cvt_pk_bf16(bf_lo(xo.w) + a1[2], bf_hi(xo.w) + a1[3]);
                    *(u32x4*)(XB + (size_t)row * DM + col0 + bj * HALF) = w;
#pragma unroll
                    for (int e = 0; e < 4; ++e) { const float lo = bf_lo(w[e]), hi = bf_hi(w[e]); ss += lo * lo + hi * hi; }
                }
                ss += __shfl_xor(ss, 16); ss += __shfl_xor(ss, 32);
                if (fq == 0) ssq_next[(size_t)row * 32 + (u.pn & 7) * 4 + wc] = ss; }
        }
    }
};
struct EpiH {
    static constexpr bool PERM = true, NEEDS_RSTD = true;
    bf16_t* H; const float* ssq;
    __device__ __forceinline__ void operator()(const f32x4 (&acc)[2][2][4][2], const Unit& u, int ui, const LAS float* rtab, int wr, int wc, int fr, int fq) const {
        const int row0 = u.pm * BM + wr * 64 + fr, col0 = u.pn * BM + wc * 32 + 8 * fq;
#pragma unroll
        for (int ai = 0; ai < 2; ++ai)
#pragma unroll
            for (int m = 0; m < 4; ++m) {
                const int row = row0 + ai * HALF + m * 16; const float rs = rtab[ui * 256 + wr * 64 + fr + ai * HALF + m * 16];
#pragma unroll
                for (int bj = 0; bj < 2; ++bj) {
                    f32x4 v0 = acc[ai][bj][m][0] * rs, v1 = acc[ai][bj][m][1] * rs;
#pragma unroll
                    for (int e = 0; e < 4; ++e) { const float a = fmaxf(v0[e], 0.f), b = fmaxf(v1[e], 0.f); v0[e] = a * a; v1[e] = b * b; }
                    u32x4 w; w.x = cvt_pk_bf16(v0[0], v0[1]); w.y = cvt_pk_bf16(v0[2], v0[3]); w.z = cvt_pk_bf16(v1[0], v1[1]); w.w = cvt_pk_bf16(v1[2], v1[3]);
                    *(u32x4*)(H + (size_t)row * DFF + col0 + bj * HALF) = w;
                }
            }
    }
};
struct EpiGlu {
    static constexpr bool PERM = true, NEEDS_RSTD = false;
    const bf16_t* Y; bf16_t* MG;
    __device__ __forceinline__ void operator()(const f32x4 (&acc)[2][2][4][2], const Unit& u, int ui, const LAS float* rtab, int wr, int wc, int fr, int fq) const {
        const int row0 = u.pm * BM + wr * 64 + fr, col0 = u.pn * BM + wc * 32 + 8 * fq;
#pragma unroll
        for (int ai = 0; ai < 2; ++ai)
#pragma unroll
            for (int m = 0; m < 4; ++m) {
                const int row = row0 + ai * HALF + m * 16;
#pragma unroll
                for (int bj = 0; bj < 2; ++bj) {
                    const int col = col0 + bj * HALF; const u32x4 yv = *(const u32x4*)(Y + (size_t)row * 1024 + col);
                    const f32x4 a0 = acc[ai][bj][m][0], a1 = acc[ai][bj][m][1]; float o[8];
                    const float yy[8] = {bf_lo(yv.x), bf_hi(yv.x), bf_lo(yv.y), bf_hi(yv.y), bf_lo(yv.z), bf_hi(yv.z), bf_lo(yv.w), bf_hi(yv.w)};
#pragma unroll
                    for (int e = 0; e < 4; ++e) { o[e] = yy[e] / (1.0f + __expf(-a0[e])); o[4 + e] = yy[4 + e] / (1.0f + __expf(-a1[e])); }
                    u32x4 w; w.x = cvt_pk_bf16(o[0], o[1]); w.y = cvt_pk_bf16(o[2], o[3]); w.z = cvt_pk_bf16(o[4], o[5]); w.w = cvt_pk_bf16(o[6], o[7]);
                    *(u32x4*)(MG + (size_t)row * DM + 1024 + col) = w;
                }
            }
    }
};
struct EpiP1 {
    static constexpr bool PERM = false, NEEDS_RSTD = false;
    float* Z;
    __device__ __forceinline__ void operator()(const f32x4 (&acc)[2][2][4][2], const Unit& u, int ui, const LAS float* rtab, int wr, int wc, int fr, int fq) const {
        const int row0 = u.pm * BM + wr * 64 + fr, col0 = wc * 32 + 4 * fq;
#pragma unroll
        for (int ai = 0; ai < 2; ++ai)
#pragma unroll
            for (int m = 0; m < 4; ++m) { float* rowp = Z + (size_t)(row0 + ai * HALF + m * 16) * 256 + col0;
#pragma unroll
                for (int bj = 0; bj < 2; ++bj)
#pragma unroll
                    for (int n = 0; n < 2; ++n) *(f32x4*)(rowp + bj * HALF + n * 16) = acc[ai][bj][m][n]; }
    }
};
__device__ __forceinline__ float gelu_tanh(float x) { const float z = 0.7978845608f * (x + 0.044715f * x * x * x); const float th = 1.0f - 2.0f / (__expf(2.0f * z) + 1.0f); return 0.5f * x * (1.0f + th); }
struct EpiP3 {
    static constexpr bool PERM = true, NEEDS_RSTD = false;
    bf16_t* Y;
    __device__ __forceinline__ void operator()(const f32x4 (&acc)[2][2][4][2], const Unit& u, int ui, const LAS float* rtab, int wr, int wc, int fr, int fq) const {
        const int g = u.pm; const int n0 = wr * 64 + fr; const int lc0 = (u.pn & 1) * 256 + wc * 32 + 8 * fq;
#pragma unroll
        for (int ai = 0; ai < 2; ++ai)
#pragma unroll
            for (int m = 0; m < 4; ++m) {
                const int n = n0 + ai * HALF + m * 16;
#pragma unroll
                for (int bj = 0; bj < 2; ++bj) {
                    const int lc = lc0 + bj * HALF, t = lc >> 4, co = lc & 15; const int token = n * 32 + t;
                    const f32x4 a0 = acc[ai][bj][m][0], a1 = acc[ai][bj][m][1];
                    u32x4 w; w.x = cvt_pk_bf16(gelu_tanh(a0[0]), gelu_tanh(a0[1])); w.y = cvt_pk_bf16(gelu_tanh(a0[2]), gelu_tanh(a0[3]));
                    w.z = cvt_pk_bf16(gelu_tanh(a1[0]), gelu_tanh(a1[1])); w.w = cvt_pk_bf16(gelu_tanh(a1[2]), gelu_tanh(a1[3]));
                    *(u32x4*)(Y + (size_t)token * 1024 + 16 * g + co) = w;
                }
            }
    }
};

template <class Epi, class Sched>
__device__ __forceinline__ void gemm_phase(LAS unsigned char* lds, const Gemm g, const Sched& S, const Epi& E) {
    int tid = threadIdx.x; asm volatile("" : "+v"(tid));
    const int wid = __builtin_amdgcn_readfirstlane(tid >> 6), lane = tid & 63, wr = wid >> 2, wc = wid & 3, fr = lane & 15, fq = lane >> 4;
    const int K = g.K, nt = K / BK;
    unsigned voffA[2], voffB[2];
#pragma unroll
    for (int i = 0; i < 2; ++i) { int R, C; stage_rc(tid * 16 + i * 8192, R, C); const int Rb = Epi::PERM ? ((R & ~31) + perm32(R & 31)) : R;
        voffA[i] = (unsigned)(R * g.lda + C) * 2u; voffB[i] = (unsigned)(Rb * g.ldb + C) * 2u; }
    const size_t kstep = (size_t)(BK * 2);
    const size_t hstepA = (size_t)HALF * g.lda * 2, hstepB = (size_t)HALF * g.ldb * 2;
    const size_t tstepA = 2 * hstepA, tstepB = 2 * hstepB;
    const unsigned ldsw = (unsigned)wid * 1024u;
    const int aoff = lds_byte(wr * 64 + fr, fq * 8), boff = lds_byte(wc * 32 + fr, fq * 8);
#define PG8_SA(b, h) (((b) * 2 + (h)) * HTB)
#define PG8_SB(b, h) ((4 + (b) * 2 + (h)) * HTB)
#define PG8_STAGE(bufoff, gbase, voff) do { _Pragma("unroll") for (int _i = 0; _i < 2; ++_i) \
        __builtin_amdgcn_global_load_lds((const unsigned*)((const char*)(gbase) + (voff)[_i]), (LAS unsigned*)(lds + (bufoff) + ldsw + _i * 8192), 16, 0, 0); } while (0)
#define PG8_LDA(dst, b, h) do { _Pragma("unroll") for (int m = 0; m < 4; ++m) _Pragma("unroll") for (int k = 0; k < 2; ++k) dst[m][k] = *(const LAS bf16x8*)(lds + PG8_SA(b, h) + aoff + m * 2048 + k * 1024); } while (0)
#define PG8_LDB(dst, b, h) do { _Pragma("unroll") for (int n = 0; n < 2; ++n) _Pragma("unroll") for (int k = 0; k < 2; ++k) dst[n][k] = *(const LAS bf16x8*)(lds + PG8_SB(b, h) + boff + n * 2048 + k * 1024); } while (0)
#define PG8_MMA(ai, bj, At, Bt) do { __builtin_amdgcn_s_setprio(1); _Pragma("unroll") for (int m = 0; m < 4; ++m) _Pragma("unroll") for (int n = 0; n < 2; ++n) _Pragma("unroll") for (int k = 0; k < 2; ++k) \
        acc[ai][bj][m][n] = __builtin_amdgcn_mfma_f32_16x16x32_bf16(Bt[n][k], At[m][k], acc[ai][bj][m][n], 0, 0, 0); __builtin_amdgcn_s_setprio(0); } while (0)
#define PG8_WAIT_V(n) asm volatile("s_waitcnt vmcnt(" #n ")" ::: "memory")
#define PG8_WAIT_L(n) asm volatile("s_waitcnt lgkmcnt(" #n ")" ::: "memory")
#define PG8_BAR __builtin_amdgcn_s_barrier()
#define PG8_SCHED __builtin_amdgcn_sched_barrier(0)
    Unit cur, nxt; int ui = 0;
    if (!S.next(0, cur)) return;

    f32x4 acc[2][2][4][2];
#pragma unroll
    for (int a = 0; a < 2; ++a)
#pragma unroll
        for (int b = 0; b < 2; ++b)
#pragma unroll
            for (int m = 0; m < 4; ++m)
#pragma unroll
                for (int n = 0; n < 2; ++n) acc[a][b][m][n] = (f32x4){0.f, 0.f, 0.f, 0.f};
    bf16x8 At[4][2], B0[2][2], B1[2][2];
    const char* cA = (const char*)g.A + (size_t)cur.pm * tstepA; const char* cB = (const char*)g.Bt + (size_t)cur.pn * tstepB;
    PG8_STAGE(PG8_SB(0, 0), cB, voffB); PG8_STAGE(PG8_SA(0, 0), cA, voffA); PG8_STAGE(PG8_SB(0, 1), cB + hstepB, voffB); PG8_STAGE(PG8_SA(0, 1), cA + hstepA, voffA);
    if constexpr (Epi::NEEDS_RSTD) {
        LAS float* rt = (LAS float*)(lds + STAGE_BYTES);
        for (int i = tid >> 8; i < 4; i += 2) { Unit uu; if (!S.next(i, uu)) break; rt[i * 256 + (tid & 255)] = row_rstd(E.ssq, uu.pm * BM + (tid & 255)); }
        __syncthreads();
    }
    if (wr == 1) PG8_BAR;
    PG8_WAIT_V(4); PG8_BAR;
    PG8_STAGE(PG8_SB(1, 0), cB + kstep, voffB); PG8_STAGE(PG8_SA(1, 0), cA + kstep, voffA); PG8_STAGE(PG8_SB(1, 1), cB + hstepB + kstep, voffB);
    PG8_WAIT_V(6); PG8_BAR;
    for (;;) {
        const bool has_next = S.next(ui + 1, nxt);
        const char* nA = has_next ? (const char*)g.A + (size_t)nxt.pm * tstepA : cA; const char* nB = has_next ? (const char*)g.Bt + (size_t)nxt.pn * tstepB : cB;
        for (int t = 0; t < nt; t += 2) {
            const bool last = (t == nt - 2);
            const char* a1 = cA + (size_t)(t + 1) * kstep;
            const char* a2 = last ? nA : cA + (size_t)(t + 2) * kstep; const char* b2 = last ? nB : cB + (size_t)(t + 2) * kstep;
            const char* a3 = a2 + kstep; const char* b3 = b2 + kstep;
            PG8_LDB(B0, 0, 0); PG8_SCHED; PG8_LDA(At, 0, 0); PG8_STAGE(PG8_SA(1, 1), a1 + hstepA, voffA);
            PG8_WAIT_L(8); PG8_BAR; PG8_WAIT_L(0); PG8_MMA(0, 0, At, B0); PG8_BAR; PG8_SCHED;
            PG8_LDB(B1, 0, 1); PG8_STAGE(PG8_SB(0, 0), b2, voffB);
            PG8_BAR; PG8_WAIT_L(0); PG8_MMA(0, 1, At, B1); PG8_BAR;
            PG8_LDA(At, 0, 1); PG8_STAGE(PG8_SA(0, 0), a2, voffA);
            PG8_BAR; PG8_WAIT_L(0); PG8_MMA(1, 0, At, B0); PG8_BAR; PG8_SCHED;
            PG8_STAGE(PG8_SB(0, 1), b2 + hstepB, voffB);
            PG8_WAIT_V(6); PG8_BAR; PG8_MMA(1, 1, At, B1); PG8_BAR;
            PG8_LDB(B0, 1, 0); PG8_SCHED; PG8_LDA(At, 1, 0); PG8_STAGE(PG8_SA(0, 1), a2 + hstepA, voffA);
            PG8_WAIT_L(8); PG8_BAR; PG8_WAIT_L(0); PG8_MMA(0, 0, At, B0); PG8_BAR; PG8_SCHED;
            PG8_LDB(B1, 1, 1); PG8_STAGE(PG8_SB(1, 0), b3, voffB);
            PG8_BAR; PG8_WAIT_L(0); PG8_MMA(0, 1, At, B1); PG8_BAR;
            PG8_LDA(At, 1, 1); PG8_STAGE(PG8_SA(1, 0), a3, voffA);
            PG8_BAR; PG8_WAIT_L(0); PG8_MMA(1, 0, At, B0); PG8_BAR; PG8_SCHED;
            PG8_STAGE(PG8_SB(1, 1), b3 + hstepB, voffB);
            PG8_WAIT_V(6); PG8_BAR; PG8_MMA(1, 1, At, B1); PG8_BAR;
        }
        E(acc, cur, ui, (const LAS float*)(lds + STAGE_BYTES), wr, wc, fr, fq);
        if (!has_next) break;
#pragma unroll
        for (int a = 0; a < 2; ++a)
#pragma unroll
            for (int b = 0; b < 2; ++b)
#pragma unroll
                for (int m = 0; m < 4; ++m)
#pragma unroll
                    for (int n = 0; n < 2; ++n) acc[a][b][m][n] = (f32x4){0.f, 0.f, 0.f, 0.f};
        cur = nxt; cA = nA; cB = nB; ++ui;
    }
    PG8_WAIT_V(0);
    if (wr == 0) PG8_BAR;
    PG8_BAR;
#undef PG8_SA
#undef PG8_SB
#undef PG8_STAGE
#undef PG8_LDA
#undef PG8_LDB
#undef PG8_MMA
#undef PG8_WAIT_V
#undef PG8_WAIT_L
#undef PG8_BAR
#undef PG8_SCHED
}

__device__ __forceinline__ void conv_issue(const float* src, int N, int tile, int lane, f32x4 (&v)[8]) {
    const int tn = N >> 5; const int k0 = (tile / tn) * 64, n0 = (tile % tn) * 32; const int kg = lane & 7, jn = lane >> 3;
    const float* sp = src + (size_t)(k0 + 8 * kg) * N + n0 + 4 * jn;
#pragma unroll
    for (int r = 0; r < 8; ++r) v[r] = *(const f32x4*)(sp + (size_t)r * N);
}
__device__ __forceinline__ void conv_finish(bf16_t* dst, int K, int N, int tile, int lane, f32x4 (&v)[8], const float* gk) {
    const int tn = N >> 5; const int k0 = (tile / tn) * 64, n0 = (tile % tn) * 32; const int kg = lane & 7, jn = lane >> 3;
    if (gk) { const f32x4 g0 = *(const f32x4*)(gk + k0 + 8 * kg), g1 = *(const f32x4*)(gk + k0 + 8 * kg + 4);
#pragma unroll
        for (int r = 0; r < 4; ++r) { v[r] *= g0[r]; v[4 + r] *= g1[r]; } }
#pragma unroll
    for (int i = 0; i < 4; ++i) { u32x4 w; w.x = cvt_pk_bf16(v[0][i], v[1][i]); w.y = cvt_pk_bf16(v[2][i], v[3][i]); w.z = cvt_pk_bf16(v[4][i], v[5][i]); w.w = cvt_pk_bf16(v[6][i], v[7][i]);
        *(u32x4*)(dst + (size_t)(n0 + 4 * jn + i) * K + k0 + 8 * kg) = w; }
}
constexpr int KSTR = 272, VSTR = 288, AROWS = 272;
constexpr int LDSA_K = 0, LDSA_V = AROWS * KSTR, LDS_TAB = LDSA_V + AROWS * VSTR;
constexpr int LDSC_V = 0, LDSC_K = 192 * VSTR;
constexpr int LDS_BYTES = LDS_TAB + 2048;

constexpr float LOG2E = 1.4426950408889634f, LN2 = 0.6931471805599453f, DEFER_THR = 11.0f;
typedef short v4i16_t __attribute__((ext_vector_type(4)));
__device__ __forceinline__ s16x4 tr_read(LAS const unsigned char* p) { return __builtin_bit_cast(s16x4, __builtin_amdgcn_ds_read_tr16_b64_v4i16((LAS v4i16_t*)p)); }

__device__ __forceinline__ void store_o_rows(bf16_t* rowp, const f32x4 (&O)[8], float inv, int g) {
    bf16_t* p = rowp + 4 * (g & ~1) + 16 * (g & 1);
#pragma unroll
    for (int k = 0; k < 4; ++k) {
        const f32x4 e = O[2 * k] * inv, o = O[2 * k + 1] * inv;
        const unsigned e0 = cvt_pk_bf16(e[0], e[1]), e1 = cvt_pk_bf16(e[2], e[3]), o0 = cvt_pk_bf16(o[0], o[1]), o1 = cvt_pk_bf16(o[2], o[3]);
        auto r0 = __builtin_amdgcn_permlane16_swap(e0, o0, false, false);
        auto r1 = __builtin_amdgcn_permlane16_swap(e1, o1, false, false);
        u32x4 w; w.x = r0[0]; w.y = r1[0]; w.z = r0[1]; w.w = r1[1];
        *(u32x4*)(p + 32 * k) = w;
    }
}
template <int LDS_K>
__device__ __forceinline__ void attn_qk(LAS const unsigned char* lds, int rowa, int rowb, const bf16x8 (&qf)[4], int lane, f32x4& sa, f32x4& sb) {
    const int fr = lane & 15, g = lane >> 4;
    sa = (f32x4){0.f, 0.f, 0.f, 0.f}; sb = sa;
    LAS const unsigned char* pa = lds + LDS_K + (rowa + fr) * KSTR + g * 16;
    LAS const unsigned char* pb = lds + LDS_K + (rowb + fr) * KSTR + g * 16;
#pragma unroll
    for (int s = 0; s < 4; ++s) {
        const bf16x8 ka = *(const LAS bf16x8*)(pa + s * 64), kb = *(const LAS bf16x8*)(pb + s * 64);
        sa = __builtin_amdgcn_mfma_f32_16x16x32_bf16(ka, qf[s], sa, 0, 0, 0);
        sb = __builtin_amdgcn_mfma_f32_16x16x32_bf16(kb, qf[s], sb, 0, 0, 0);
    }
}
template <int LDS_V>
__device__ __forceinline__ void attn_pv(LAS const unsigned char* lds, int rowa, int rowb, const f32x4 sa, const f32x4 sb, f32x4 (&O)[8], float& m_run, float& l_run, int lane) {
    const int g = lane >> 4, ii = lane & 15;
    float mx = fmaxf(fmaxf(fmaxf(sa[0], sa[1]), fmaxf(sa[2], sa[3])), fmaxf(fmaxf(sb[0], sb[1]), fmaxf(sb[2], sb[3])));
    if (__builtin_amdgcn_ballot_w64(mx > m_run + DEFER_THR) != 0ull) {
        mx = fmaxf(mx, __shfl_xor(mx, 16)); mx = fmaxf(mx, __shfl_xor(mx, 32));
        const float m_new = fmaxf(m_run, mx);
        const float alpha = __builtin_amdgcn_exp2f(m_run - m_new);
        l_run *= alpha; m_run = m_new;
#pragma unroll
        for (int cb = 0; cb < 8; ++cb) O[cb] *= alpha;
    }
    float pa[4], pb[4]; float sum = 0.f;
#pragma unroll
    for (int j = 0; j < 4; ++j) { pa[j] = __builtin_amdgcn_exp2f(sa[j] - m_run); pb[j] = __builtin_amdgcn_exp2f(sb[j] - m_run); sum += pa[j] + pb[j]; }
    l_run += sum;
    u32x4 pw; pw.x = cvt_pk_bf16_t(pa[0], pa[1]); pw.y = cvt_pk_bf16_t(pa[2], pa[3]); pw.z = cvt_pk_bf16_t(pb[0], pb[1]); pw.w = cvt_pk_bf16_t(pb[2], pb[3]);
    const bf16x8 pf = __builtin_bit_cast(bf16x8, pw);
    LAS const unsigned char* va = lds + LDS_V + (rowa + 4 * g + (ii >> 2)) * VSTR + (ii & 3) * 8;
    LAS const unsigned char* vb = lds + LDS_V + (rowb + 4 * g + (ii >> 2)) * VSTR + (ii & 3) * 8;
#pragma unroll
    for (int cb = 0; cb < 8; ++cb) {
        const s16x4 lo = tr_read(va + cb * 32), hi = tr_read(vb + cb * 32);
        bf16x8 vf; vf[0] = lo[0]; vf[1] = lo[1]; vf[2] = lo[2]; vf[3] = lo[3]; vf[4] = hi[0]; vf[5] = hi[1]; vf[6] = hi[2]; vf[7] = hi[3];
        O[cb] = __builtin_amdgcn_mfma_f32_16x16x32_bf16(vf, pf, O[cb], 0, 0, 0);
    }
}

struct AItem { int bi, h, b, d, r, nb, L; };
__device__ __forceinline__ AItem a_decode(int item) { AItem a; a.bi = item & 63; a.h = (item >> 6) & 7; a.b = item >> 9; const int sh = 2 * a.b; a.d = 1 << sh; a.r = a.bi & (a.d - 1); a.nb = a.bi >> sh; a.L = SEQ >> sh; return a; }
__device__ __forceinline__ void a_load(int item, int tid, const bf16_t* Kb, const bf16_t* Vb, u32x4 (&kv)[8], u32x4 (&vv)[8]) {
    const AItem a = a_decode(item);
#pragma unroll
    for (int it = 0; it < 8; ++it) {
        const int cid = tid + NTHR * it, row = cid >> 4, ch = cid & 15; const int l = a.nb * 128 + row - 64;
        if (l >= 0 && l < a.L) { const size_t off = ((size_t)(l * a.d + a.r) * 1024 + a.h * 128 + ch * 8); kv[it] = *(const u32x4*)(Kb + off); vv[it] = *(const u32x4*)(Vb + off); }
        else { kv[it] = (u32x4){0u, 0u, 0u, 0u}; vv[it] = kv[it]; }
    }
}
__device__ __forceinline__ void a_store(LAS unsigned char* lds, int item, int tid, const float* t5, const u32x4 (&kv)[8], const u32x4 (&vv)[8]) {
    const AItem a = a_decode(item); LAS float* tab = (LAS float*)(lds + LDS_TAB);
#pragma unroll
    for (int it = 0; it < 8; ++it) { const int cid = tid + NTHR * it, row = cid >> 4, ch = cid & 15;
        *(LAS u32x4*)(lds + LDSA_K + row * KSTR + ch * 16) = kv[it]; *(LAS u32x4*)(lds + LDSA_V + row * VSTR + ch * 16) = vv[it]; }
    if (tid < 129) { const int rel = (tid - 64) * a.d; const int n = rel < 0 ? -rel : rel; int bk;
        if (n < 8) bk = n; else { int lg = 8 + (int)(logf((float)n / 8.0f) / 4.852030263919617f * 8.0f); bk = lg < 15 ? lg : 15; }
        if (rel > 0) bk += 16;
        tab[tid] = t5[bk * 8 + a.h] * LOG2E; }
}
__device__ __forceinline__ void a_compute(LAS unsigned char* lds, int item, int tid, const bf16x8 (&qf)[4], float* NUM, float* ML) {
    const int wid = __builtin_amdgcn_readfirstlane(tid >> 6), lane = tid & 63, fr = lane & 15, g = lane >> 4;
    const AItem a = a_decode(item); const int nb = a.nb, L = a.L, d = a.d, r = a.r, h = a.h, b = a.b;
    LAS float* tab = (LAS float*)(lds + LDS_TAB);
    const int i0 = 16 * wid, qi = i0 + fr; const int qpos = (nb * 128 + qi) * d + r;
    f32x4 O[8];
#pragma unroll
    for (int cb = 0; cb < 8; ++cb) O[cb] = (f32x4){0.f, 0.f, 0.f, 0.f};
    float m_run = -1e30f, l_run = 0.f;
    const float scale = 0.08838834764831845f * LOG2E;
    for (int pp = 0; pp < 5; ++pp) {
        const int rowa = i0 + 32 * pp, rowb = rowa + 16;
        f32x4 sa, sb; attn_qk<LDSA_K>(lds, rowa, rowb, qf, lane, sa, sb);
        {
            const int rela = rowa + 4 * g - qi, la = nb * 128 + rowa + 4 * g - 64; float ba[4], bb[4];
#pragma unroll
            for (int j = 0; j < 4; ++j) { int ta = rela + j; ta = ta < 0 ? 0 : (ta > 128 ? 128 : ta); int tb = rela + 16 + j; tb = tb < 0 ? 0 : (tb > 128 ? 128 : tb); ba[j] = tab[ta]; bb[j] = tab[tb]; }
#pragma unroll
            for (int j = 0; j < 4; ++j) {
                const int ra = rela + j, rb = rela + 16 + j, l0 = la + j, l1 = la + 16 + j;
                const bool oka = ((unsigned)ra <= 128u) && ((unsigned)l0 < (unsigned)L), okb = ((unsigned)rb <= 128u) && ((unsigned)l1 < (unsigned)L);
                const float va = fmaf(sa[j], scale, ba[j]), vb = fmaf(sb[j], scale, bb[j]);
                sa[j] = oka ? va : -INFINITY; sb[j] = okb ? vb : -INFINITY;
            }
        }
        attn_pv<LDSA_V>(lds, rowa, rowb, sa, sb, O, m_run, l_run, lane);
    }
    l_run += __shfl_xor(l_run, 16); l_run += __shfl_xor(l_run, 32);
    if (g == 0) { f32x2 ml; ml.x = m_run * LN2; ml.y = l_run; *(f32x2*)(ML + ((size_t)(b * 8 + h) * SEQ + qpos) * 2) = ml; }
    const float inv = 1.0f / l_run;
    store_o_rows((bf16_t*)NUM + ((size_t)b * SEQ + qpos) * 1024 + h * 128, O, inv, g);
}
__device__ __forceinline__ void attn_a_phase(LAS unsigned char* lds, int first, int stride, int count, const bf16_t* Qb, const bf16_t* Kb, const bf16_t* Vb, const float* t5, float* NUM, float* ML) {
    int tid = threadIdx.x; asm volatile("" : "+v"(tid));
    if (count <= 0) return;
    if (tid < 256) { const int row = 256 + (tid >> 4), ch = tid & 15; const u32x4 z = (u32x4){0u, 0u, 0u, 0u};
        *(LAS u32x4*)(lds + LDSA_K + row * KSTR + ch * 16) = z; *(LAS u32x4*)(lds + LDSA_V + row * VSTR + ch * 16) = z; }
    u32x4 kv[8], vv[8];
    a_load(first, tid, Kb, Vb, kv, vv);
    for (int k = 0; k < count; ++k) {
        const int item = first + k * stride;
        a_store(lds, item, tid, t5, kv, vv);
        __syncthreads();
        bf16x8 qf[4];
        { const AItem a = a_decode(item); const int wid = __builtin_amdgcn_readfirstlane(tid >> 6), lane = tid & 63; const int qpos = (a.nb * 128 + 16 * wid + (lane & 15)) * a.d + a.r;
#pragma unroll
          for (int s = 0; s < 4; ++s) qf[s] = *(const bf16x8*)(Qb + (size_t)qpos * 1024 + a.h * 128 + s * 32 + (lane >> 4) * 8); }
        if (k + 1 < count) a_load(item + stride, tid, Kb, Vb, kv, vv);
        a_compute(lds, item, tid, qf, NUM, ML);
        __syncthreads();
    }
}

__device__ __forceinline__ void attn_a_merge(const float* NUM, const float* ML, bf16_t* MG, int first, int stride, int lo, int hi) {
    const bf16_t* NB = (const bf16_t*)NUM;
    for (int it = lo + first; it < hi; it += stride) {
        const int token = it >> 7, c8 = (it & 127) * 8, h = c8 >> 7;
        const f32x2 a = *(const f32x2*)(ML + ((size_t)(0 * 8 + h) * SEQ + token) * 2), b = *(const f32x2*)(ML + ((size_t)(1 * 8 + h) * SEQ + token) * 2), c = *(const f32x2*)(ML + ((size_t)(2 * 8 + h) * SEQ + token) * 2);
        const float M = fmaxf(a.x, fmaxf(b.x, c.x)); float wa = __expf(a.x - M) * a.y, wb = __expf(b.x - M) * b.y, wc = __expf(c.x - M) * c.y;
        const float inv = 1.0f / (wa + wb + wc); wa *= inv; wb *= inv; wc *= inv;
        const u32x4 na = *(const u32x4*)(NB + ((size_t)0 * SEQ + token) * 1024 + c8), nb = *(const u32x4*)(NB + ((size_t)1 * SEQ + token) * 1024 + c8), nc = *(const u32x4*)(NB + ((size_t)2 * SEQ + token) * 1024 + c8);
        u32x4 w;
#pragma unroll
        for (int e = 0; e < 4; ++e) { const float lo_ = bf_lo(na[e]) * wa + bf_lo(nb[e]) * wb + bf_lo(nc[e]) * wc, hi_ = bf_hi(na[e]) * wa + bf_hi(nb[e]) * wb + bf_hi(nc[e]) * wc; w[e] = cvt_pk_bf16(lo_, hi_); }
        *(u32x4*)(MG + (size_t)token * DM + c8) = w;
    }
}

__device__ __forceinline__ int c_rs0(int item) { const int r0 = 2 * (item >> 4); return (r0 - 4) < 0 ? 0 : ((r0 - 4) > 120 ? 120 : (r0 - 4)); }
__device__ __forceinline__ void c_load(int item, int ci, int tid, const bf16_t* Kb, const bf16_t* Vb, u32x4 (&kv)[6], u32x4 (&vv)[6]) {
    const int h = item & 15, rs0 = c_rs0(item);
#pragma unroll
    for (int it = 0; it < 6; ++it) {
        const int cid = tid + NTHR * it, row = cid >> 4, ch = cid & 15; const int kr = rs0 + 3 * ci + (row >> 6), kc = row & 63;
        if (kr < 128) { const size_t off = ((size_t)(kr * 64 + kc) * DM + h * 128 + ch * 8); kv[it] = *(const u32x4*)(Kb + off); vv[it] = *(const u32x4*)(Vb + off); }
        else { kv[it] = (u32x4){0u, 0u, 0u, 0u}; vv[it] = kv[it]; }
    }
}
__device__ __forceinline__ void c_store(LAS unsigned char* lds, int tid, const u32x4 (&kv)[6], const u32x4 (&vv)[6]) {
#pragma unroll
    for (int it = 0; it < 6; ++it) { const int cid = tid + NTHR * it, row = cid >> 4, ch = cid & 15;
        *(LAS u32x4*)(lds + LDSC_K + row * KSTR + ch * 16) = kv[it]; *(LAS u32x4*)(lds + LDSC_V + row * VSTR + ch * 16) = vv[it]; }
}
__device__ __forceinline__ void attn_c_phase(LAS unsigned char* lds, int first, int stride, const bf16_t* Qb, const bf16_t* Kb, const bf16_t* Vb, const float* rpb, bf16_t* MG,
                                             const float* w1s, bf16_t* w1d, const float* w2s, bf16_t* w2d, const float* g1) {
    int tid = threadIdx.x; asm volatile("" : "+v"(tid));
    if (first >= 1024) return;
    const int wid = __builtin_amdgcn_readfirstlane(tid >> 6), lane = tid & 63, fr = lane & 15, g = lane >> 4;
    LAS float* tab = (LAS float*)(lds + LDS_TAB);
    const int rsel = wid >> 2, ct = wid & 3;
    const int colbase = (ct == 0) ? 0 : ((ct == 1) ? 8 : ((ct == 2) ? 24 : 32));
    const int qc = 16 * ct + fr; const int cws = (qc - 8) < 0 ? 0 : ((qc - 8) > 48 ? 48 : (qc - 8));
    const float scale = 0.08838834764831845f * LOG2E;
    u32x4 kv[6], vv[6];
    c_load(first, 0, tid, Kb, Vb, kv, vv);
    bf16x8 qf[4]; f32x4 O[8]; float m_run = -1e30f, l_run = 0.f;
    for (int item = first; item < 1024; item += stride) {
        const int h = item & 15, r0 = 2 * (item >> 4), rs0 = c_rs0(item);
        const int qr = r0 + rsel, token = qr * 64 + qc;
        const int rws = (qr - 4) < 0 ? 0 : ((qr - 4) > 120 ? 120 : (qr - 4));
#pragma unroll
        for (int s = 0; s < 4; ++s) qf[s] = *(const bf16x8*)(Qb + (size_t)token * DM + h * 128 + s * 32 + g * 8);
#pragma unroll
        for (int cb = 0; cb < 8; ++cb) O[cb] = (f32x4){0.f, 0.f, 0.f, 0.f};
        m_run = -1e30f; l_run = 0.f;
        for (int ci = 0; ci < 3; ++ci) {
            c_store(lds, tid, kv, vv);
            if (ci == 0 && tid < 465) tab[tid] = rpb[h * 465 + tid] * LOG2E;
            __syncthreads();
            if (ci < 2) c_load(item, ci + 1, tid, Kb, Vb, kv, vv);
            else if (item + stride < 1024) c_load(item + stride, 0, tid, Kb, Vb, kv, vv);
            f32x4 cv[8]; const int ctile = item * 8 + wid;
            if (ci == 1) conv_issue(w2s, DM, ctile, lane, cv);
            for (int lr = 0; lr < 3; ++lr) {
                const int kr = rs0 + 3 * ci + lr;
                if (kr < rws || kr >= rws + 8) continue;
                const int rowa = lr * 64 + colbase, rowb = rowa + 16;
                f32x4 sa, sb; attn_qk<LDSC_K>(lds, rowa, rowb, qf, lane, sa, sb);
                const int tb = (kr - qr + 7) * 31 + 15 - qc; const int kc0 = colbase + 4 * g; float ba[4], bb[4];
#pragma unroll
                for (int j = 0; j < 4; ++j) { int ta = tb + kc0 + j; ta = ta < 0 ? 0 : (ta > 464 ? 464 : ta); int t2 = tb + kc0 + 16 + j; t2 = t2 < 0 ? 0 : (t2 > 464 ? 464 : t2); ba[j] = tab[ta]; bb[j] = tab[t2]; }
#pragma unroll
                for (int j = 0; j < 4; ++j) {
                    const bool oka = (unsigned)(kc0 + j - cws) < 16u, okb = (unsigned)(kc0 + 16 + j - cws) < 16u;
                    const float va = fmaf(sa[j], scale, ba[j]), vb = fmaf(sb[j], scale, bb[j]);
                    sa[j] = oka ? va : -INFINITY; sb[j] = okb ? vb : -INFINITY;
                }
                attn_pv<LDSC_V>(lds, rowa, rowb, sa, sb, O, m_run, l_run, lane);
            }
            if (ci == 1) conv_finish(w2d, DFF, DM, ctile, lane, cv, nullptr);
            __syncthreads();
        }
        l_run += __shfl_xor(l_run, 16); l_run += __shfl_xor(l_run, 32);
        const float inv = 1.0f / l_run;
        store_o_rows(MG + (size_t)token * DM + h * 128, O, inv, g);
    }
}

__device__ __forceinline__ void s5_gen(LAS unsigned char* lds, const Params& P, int j, int g) {
    const int tid = threadIdx.x;
    LAS f32x2* pw = (LAS f32x2*)lds;
    LAS f32x2* bb = (LAS f32x2*)(lds + 33792);
    LAS f32x2* cc = (LAS f32x2*)(lds + 33792 + 16384);
    LAS float* kern = (LAS float*)(lds + 33792 + 32768);
    const float* lam_re = P.in[4]; const float* lam_im = P.in[5]; const float* log_step = P.in[6];
    const float* b_re = P.in[7]; const float* b_im = P.in[8]; const float* c_re = P.in[9]; const float* c_im = P.in[10]; const float* dsk = P.in[11];
    for (int e = tid; e < 2 * 33 * 64; e += NTHR) {
        const int pp = e & 63, k = (e >> 6) % 33, dir = e / (33 * 64);
        const int idx = ((j * 2 + dir) * 64 + g) * 64 + pp;
        const float step = expf(log_step[(j * 2 + dir) * 64 + g]); const float lr = fminf(lam_re[idx], -1e-4f), li = lam_im[idx];
        const float rho = lr * step, th = li * step; const float mg = expf((float)k * rho); float sn, cs; sincosf((float)k * th, &sn, &cs);
        f32x2 v; v.x = mg * cs; v.y = mg * sn; pw[e] = v;
    }
    if (tid < 128) {
        const int dir = tid >> 6, pp = tid & 63; const int idx = ((j * 2 + dir) * 64 + g) * 64 + pp;
        const double step = exp((double)log_step[(j * 2 + dir) * 64 + g]); const double lr = fmin((double)lam_re[idx], -1e-4), li = (double)lam_im[idx];
        const double mg = exp(lr * step); const double abr = mg * cos(li * step), abi = mg * sin(li * step); const double den = lr * lr + li * li;
        const float zr = (float)(((abr - 1.0) * lr + abi * li) / den), zi = (float)((abi * lr - (abr - 1.0) * li) / den);
        for (int c = 0; c < 16; ++c) { const float br = b_re[((j * 64 + g) * 64 + pp) * 16 + c], bi = b_im[((j * 64 + g) * 64 + pp) * 16 + c];
            f32x2 v; v.x = zr * br - zi * bi; v.y = zr * bi + zi * br; bb[(dir * 64 + pp) * 16 + c] = v; }
        const double mg32 = exp(32.0 * lr * step); f32x2 a32; a32.x = (float)(mg32 * cos(32.0 * li * step)); a32.y = (float)(mg32 * sin(32.0 * li * step));
        *(f32x2*)(P.ws + WS_A32 + (size_t)idx * 8) = a32;
    }
    for (int e = tid; e < 2 * 16 * 64; e += NTHR) { const int dir = e >> 10, rem = e & 1023; const size_t gi = (size_t)((j * 2 + dir) * 64 + g) * 1024 + rem; f32x2 v; v.x = c_re[gi]; v.y = c_im[gi]; cc[e] = v; }
    __syncthreads();
    for (int e = tid; e < 1024; e += NTHR) {
        const int dir = e >> 9, tau = (e >> 4) & 31, co = e & 15; float acc16[16];
#pragma unroll
        for (int ci = 0; ci < 16; ++ci) acc16[ci] = 0.f;
        for (int pp = 0; pp < 64; ++pp) {
            const f32x2 w = pw[(dir * 33 + tau) * 64 + pp], c = cc[(dir * 16 + co) * 64 + pp];
            const float tr = c.x * w.x - c.y * w.y, ti = c.x * w.y + c.y * w.x;
            const LAS f32x4* bp = (const LAS f32x4*)(bb + (dir * 64 + pp) * 16);
#pragma unroll
            for (int q = 0; q < 8; ++q) { const f32x4 b2 = bp[q]; acc16[2 * q] += tr * b2[0] - ti * b2[1]; acc16[2 * q + 1] += tr * b2[2] - ti * b2[3]; }
        }
#pragma unroll
        for (int q = 0; q < 4; ++q) { f32x4 o; o[0] = acc16[4 * q]; o[1] = acc16[4 * q + 1]; o[2] = acc16[4 * q + 2]; o[3] = acc16[4 * q + 3]; *(LAS f32x4*)(kern + e * 16 + 4 * q) = o; }
    }
    __syncthreads();
    bf16_t* B3 = (bf16_t*)(P.ws + WS_B3 + (size_t)j * SZ_B3) + (size_t)g * 512 * 768;
    for (int ch = tid; ch < 512 * 96; ch += NTHR) {
        const int row = ch / 96, kc = (ch % 96) * 8, t = row >> 4, co = row & 15; float v[8];
        if (kc < 512) { const int s = kc >> 4, ci0 = kc & 15; f32x4 a0 = (f32x4){0.f, 0.f, 0.f, 0.f}, a1 = a0;
            if (s <= t) { const LAS f32x4* kp = (const LAS f32x4*)(kern + ((0 * 32 + (t - s)) * 16 + co) * 16 + ci0); a0 += kp[0]; a1 += kp[1]; }
            if (s >= t) { const LAS f32x4* kp = (const LAS f32x4*)(kern + ((1 * 32 + (s - t)) * 16 + co) * 16 + ci0); a0 += kp[0]; a1 += kp[1]; }
#pragma unroll
            for (int e = 0; e < 4; ++e) { v[e] = a0[e]; v[4 + e] = a1[e]; }
            if (s == t && (co >> 3) == (ci0 >> 3)) {
#pragma unroll
                for (int e = 0; e < 8; ++e) if (e == (co & 7)) v[e] += dsk[j * 1024 + 16 * g + co];
            } }
        else { const int kk = kc - 512, dir = kk >> 7, im = (kk >> 6) & 1, p0 = kk & 63; const int ex = (dir == 0) ? (t + 1) : (32 - t);
#pragma unroll
            for (int e = 0; e < 8; ++e) { const int pp = p0 + e; const f32x2 c = cc[(dir * 16 + co) * 64 + pp], w = pw[(dir * 33 + ex) * 64 + pp];
                v[e] = im ? -(c.x * w.y + c.y * w.x) : (c.x * w.x - c.y * w.y); } }
        u32x4 w; w.x = cvt_pk_bf16(v[0], v[1]); w.y = cvt_pk_bf16(v[2], v[3]); w.z = cvt_pk_bf16(v[4], v[5]); w.w = cvt_pk_bf16(v[6], v[7]);
        *(u32x4*)(B3 + (size_t)row * 768 + kc) = w;
    }
    bf16_t* B1 = (bf16_t*)(P.ws + WS_B1 + (size_t)j * SZ_B1) + (size_t)g * 256 * 512;
    for (int ch = tid; ch < 256 * 64; ch += NTHR) {
        const int row = ch >> 6, kc = (ch & 63) * 8, dir = row >> 7, im = (row >> 6) & 1, pp = row & 63, t = kc >> 4, c0 = kc & 15; const int ex = (dir == 0) ? (31 - t) : t;
        const f32x2 w = pw[(dir * 33 + ex) * 64 + pp]; float v[8];
#pragma unroll
        for (int e = 0; e < 8; ++e) { const f32x2 b = bb[(dir * 64 + pp) * 16 + c0 + e]; v[e] = im ? (w.x * b.y + w.y * b.x) : (w.x * b.x - w.y * b.y); }
        u32x4 wv; wv.x = cvt_pk_bf16(v[0], v[1]); wv.y = cvt_pk_bf16(v[2], v[3]); wv.z = cvt_pk_bf16(v[4], v[5]); wv.w = cvt_pk_bf16(v[6], v[7]);
        *(u32x4*)(B1 + (size_t)row * 512 + kc) = wv;
    }
    __syncthreads();
}

__device__ __forceinline__ void s5_carry(LAS unsigned char* lds, const Params& P, int j, int g, int dir) {
    int tid = threadIdx.x; asm volatile("" : "+v"(tid));
    const float* Z = (const float*)(P.ws + WS_Z); bf16_t* U2 = (bf16_t*)(P.ws + WS_U2);
    LAS float* zl = (LAS float*)lds;
#pragma unroll
    for (int it = 0; it < 16; ++it) { const int cid = tid + NTHR * it, n = cid >> 5, c4 = (cid & 31) * 4;
        *(LAS f32x4*)(zl + n * 128 + c4) = *(const f32x4*)(Z + (size_t)(g * 256 + n) * 256 + dir * 128 + c4); }
    __syncthreads();
    if (tid < 64) {
        const int pp = tid; const int idx = ((j * 2 + dir) * 64 + g) * 64 + pp;
        const f32x2 a32 = *(const f32x2*)(P.ws + WS_A32 + (size_t)idx * 8); const float ar = a32.x, ai = a32.y;
        float cr = 0.f, cim = 0.f;
        bf16_t* up = U2 + (size_t)g * 256 * 768 + 512 + dir * 128 + pp;
        for (int s = 0; s < 256; ++s) {
            const int n = dir ? (255 - s) : s;
            up[(size_t)n * 768] = (bf16_t)(cvt_pk_bf16(cr, 0.f) & 0xffffu); up[(size_t)n * 768 + 64] = (bf16_t)(cvt_pk_bf16(cim, 0.f) & 0xffffu);
            const float zr = zl[n * 128 + pp], zi = zl[n * 128 + 64 + pp];
            const float nr = ar * cr - ai * cim + zr, ni = ar * cim + ai * cr + zi; cr = nr; cim = ni;
        }
    }
    __syncthreads();
}

__device__ __forceinline__ void s5_carry2(const Params& P, int j, int g) {
    int tid = threadIdx.x; asm volatile("" : "+v"(tid));
    const int wid = __builtin_amdgcn_readfirstlane(tid >> 6), pp = tid & 63;
    if (wid < 2) {
        const int dir = wid; const int idx = ((j * 2 + dir) * 64 + g) * 64 + pp;
        const f32x2 a32 = *(const f32x2*)(P.ws + WS_A32 + (size_t)idx * 8); const float ar = a32.x, ai = a32.y;
        const float* zp = (const float*)(P.ws + WS_Z) + (size_t)(g * 256) * 256 + dir * 128 + pp;
        bf16_t* up = (bf16_t*)(P.ws + WS_U2) + (size_t)g * 256 * 768 + 512 + dir * 128 + pp;
        float cr = 0.f, cim = 0.f; float zr[8], zi[8], nzr[8], nzi[8];
#pragma unroll
        for (int u = 0; u < 8; ++u) { const int n = dir ? (255 - u) : u; zr[u] = zp[(size_t)n * 256]; zi[u] = zp[(size_t)n * 256 + 64]; }
        for (int s0 = 0; s0 < 256; s0 += 8) {
            if (s0 + 8 < 256) {
#pragma unroll
                for (int u = 0; u < 8; ++u) { const int n = dir ? (255 - (s0 + 8 + u)) : (s0 + 8 + u); nzr[u] = zp[(size_t)n * 256]; nzi[u] = zp[(size_t)n * 256 + 64]; }
            }
#pragma unroll
            for (int u = 0; u < 8; ++u) { const int n = dir ? (255 - (s0 + u)) : (s0 + u);
                up[(size_t)n * 768] = (bf16_t)(cvt_pk_bf16(cr, 0.f) & 0xffffu); up[(size_t)n * 768 + 64] = (bf16_t)(cvt_pk_bf16(cim, 0.f) & 0xffffu);
                const float nr = ar * cr - ai * cim + zr[u], ni = ar * cim + ai * cr + zi[u]; cr = nr; cim = ni; }
#pragma unroll
            for (int u = 0; u < 8; ++u) { zr[u] = nzr[u]; zi[u] = nzi[u]; }
        }
    }
    __syncthreads();
}

__device__ __forceinline__ void conv_tile(const float* src, bf16_t* dst, int K, int N, int tile, int lane, const float* gk) {
    const int tn = N >> 5; const int k0 = (tile / tn) * 64, n0 = (tile % tn) * 32; const int kg = lane & 7, jn = lane >> 3;
    f32x4 v[8]; const float* sp = src + (size_t)(k0 + 8 * kg) * N + n0 + 4 * jn;
#pragma unroll
    for (int r = 0; r < 8; ++r) v[r] = *(const f32x4*)(sp + (size_t)r * N);
    if (gk) { const f32x4 g0 = *(const f32x4*)(gk + k0 + 8 * kg), g1 = *(const f32x4*)(gk + k0 + 8 * kg + 4);
#pragma unroll
        for (int r = 0; r < 4; ++r) { v[r] *= g0[r]; v[4 + r] *= g1[r]; } }
#pragma unroll
    for (int i = 0; i < 4; ++i) { u32x4 w; w.x = cvt_pk_bf16(v[0][i], v[1][i]); w.y = cvt_pk_bf16(v[2][i], v[3][i]); w.z = cvt_pk_bf16(v[4][i], v[5][i]); w.w = cvt_pk_bf16(v[6][i], v[7][i]);
        *(u32x4*)(dst + (size_t)(n0 + 4 * jn + i) * K + k0 + 8 * kg) = w; }
}
constexpr int T_WIN = 4096, T_WOUT = 2048, T_GLU = 512, T_QKV = 6144, T_W1 = 8192, T_W2 = 8192;
constexpr int T_EVEN = T_WIN + T_WOUT + T_GLU + T_W1 + T_W2, T_ODD = T_QKV + T_WOUT + T_W1 + T_W2, T_PAIR = T_EVEN + T_ODD, T_ALL = 2 * T_PAIR;
__device__ __forceinline__ void conv_dispatch(const Params& P, int tile, int lane) {
    const int j = tile / T_PAIR; int rem = tile % T_PAIR; unsigned char* ws = P.ws;
    if (rem < T_EVEN) { const int i = 2 * j;
        if (rem < T_WIN) { conv_tile(P.in[2] + (size_t)j * 2048 * 4096, (bf16_t*)(ws + WS_WIN + j * SZ_WIN), 2048, 4096, rem, lane, P.in[16] + (size_t)i * DM); return; } rem -= T_WIN;
        if (rem < T_WOUT) { conv_tile(P.in[3] + (size_t)j * 2048 * 2048, (bf16_t*)(ws + WS_WOUT + j * SZ_WOUT), 2048, 2048, rem, lane, nullptr); return; } rem -= T_WOUT;
        if (rem < T_GLU) { conv_tile(P.in[12] + (size_t)j * 1024 * 1024, (bf16_t*)(ws + WS_GLU + j * SZ_GLU), 1024, 1024, rem, lane, nullptr); return; } rem -= T_GLU;
        if (rem < T_W1) { conv_tile(P.in[18] + (size_t)i * 2048 * 8192, (bf16_t*)(ws + WS_W1 + i * SZ_W1), 2048, 8192, rem, lane, P.in[17] + (size_t)i * DM); return; } rem -= T_W1;
        conv_tile(P.in[19] + (size_t)i * 8192 * 2048, (bf16_t*)(ws + WS_W2 + i * SZ_W2), 8192, 2048, rem, lane, nullptr);
    } else { rem -= T_EVEN; const int i = 2 * j + 1;
        if (rem < T_QKV) { conv_tile(P.in[13] + (size_t)j * 2048 * 6144, (bf16_t*)(ws + WS_QKV + j * SZ_QKV), 2048, 6144, rem, lane, P.in[16] + (size_t)i * DM); return; } rem -= T_QKV;
        if (rem < T_WOUT) { conv_tile(P.in[14] + (size_t)j * 2048 * 2048, (bf16_t*)(ws + WS_COUT + j * SZ_WOUT), 2048, 2048, rem, lane, nullptr); return; } rem -= T_WOUT;
        if (rem < T_W1) { conv_tile(P.in[18] + (size_t)i * 2048 * 8192, (bf16_t*)(ws + WS_W1 + i * SZ_W1), 2048, 8192, rem, lane, P.in[17] + (size_t)i * DM); return; } rem -= T_W1;
        conv_tile(P.in[19] + (size_t)i * 8192 * 2048, (bf16_t*)(ws + WS_W2 + i * SZ_W2), 8192, 2048, rem, lane, nullptr);
    }
}

#define XB_TMO      128
#define XB_XCNT(j)  (256  + 64 * (j))
#define XB_XSUB(j)  (1280 + 64 * (j))
#define XB_XGEN(j)  (2304 + 64 * (j))
#define XB_TOP      3328
#define XB_TOPGEN   3392
#define XCD_BAR_WORDS 3456
#define XB_SPIN_CAP (1u << 18)
__device__ __forceinline__ unsigned xb_ld(unsigned* p)              { return __hip_atomic_load(p, __ATOMIC_RELAXED, __HIP_MEMORY_SCOPE_AGENT); }
__device__ __forceinline__ unsigned xb_add(unsigned* p, unsigned v) { return __hip_atomic_fetch_add(p, v, __ATOMIC_RELAXED, __HIP_MEMORY_SCOPE_AGENT); }
__device__ __forceinline__ unsigned xb_xcc_id() { return (unsigned)__builtin_amdgcn_s_getreg((3 << 11) | 20) & 0xFu; }
#define XB_SPIN(cond, bar) do { unsigned _sp = 0; while (cond) { __builtin_amdgcn_s_sleep(1); \
    if ((++_sp & 255u) == 0u) { if (xb_ld(&(bar)[XB_TMO])) break; if (_sp > XB_SPIN_CAP) { atomicAdd(&(bar)[XB_TMO], 1u); break; } } } } while (0)
struct XcdBarrier { unsigned* bar; unsigned x; volatile LAS unsigned* st; };
__device__ __forceinline__ XcdBarrier xcd_barrier_post(unsigned* bar, volatile LAS unsigned* st) {
    XcdBarrier b; b.bar = bar; b.x = xb_xcc_id(); b.st = st;
    if (threadIdx.x == 0) (void)xb_add(&bar[XB_XCNT(b.x)], 1u);
    return b;
}
__device__ __forceinline__ void xcd_barrier_complete(unsigned* bar, unsigned x, unsigned& nloc, unsigned& nx) {
    const unsigned G = gridDim.x * gridDim.y * gridDim.z;
    unsigned sum, cnt, mine, sp = 0u;
    for (;;) {
        sum = 0u; cnt = 0u; mine = 0u;
#pragma unroll
        for (unsigned j = 0; j < 16; ++j) { const unsigned c = xb_ld(&bar[XB_XCNT(j)]); sum += c; cnt += (c > 0u) ? 1u : 0u; mine = (j == x) ? c : mine; }
        if (sum == G) break;
        __builtin_amdgcn_s_sleep(1);
        if ((++sp & 255u) == 0u) { if (xb_ld(&bar[XB_TMO])) break; if (sp > XB_SPIN_CAP) { atomicAdd(&bar[XB_TMO], 1u); break; } }
    }
    nloc = mine > 0u ? mine : 1u; nx = cnt > 0u ? cnt : 1u;
}
__device__ __forceinline__ void xcd_barrier(const XcdBarrier& b) {
    asm volatile("s_waitcnt vmcnt(0)" ::: "memory");
    __syncthreads();
    if (threadIdx.x == 0) {
        unsigned* bar = b.bar;
        __builtin_amdgcn_s_waitcnt(0);
        unsigned nloc = b.st[0], nx = b.st[1];
        if (nloc == 0u) { xcd_barrier_complete(bar, b.x, nloc, nx); b.st[0] = nloc; b.st[1] = nx; }
        const unsigned old = xb_add(&bar[XB_XSUB(b.x)], 1u);
        const unsigned gen = old / nloc;
        if (old + 1u == (gen + 1u) * nloc) {
            __builtin_amdgcn_fence(__ATOMIC_RELEASE, "agent");
            asm volatile("s_waitcnt vmcnt(0)" ::: "memory");
            const unsigned og = xb_add(&bar[XB_TOP], 1u);
            const unsigned tg = og / nx;
            if (og + 1u == (tg + 1u) * nx) xb_add(&bar[XB_TOPGEN], 1u);
            else XB_SPIN(xb_ld(&bar[XB_TOPGEN]) == tg, bar);
            __builtin_amdgcn_fence(__ATOMIC_ACQUIRE, "agent");
            xb_add(&bar[XB_XGEN(b.x)], 1u);
            asm volatile("s_waitcnt vmcnt(0)" ::: "memory");
        } else {
            XB_SPIN(xb_ld(&bar[XB_XGEN(b.x)]) == gen, bar);
            __builtin_amdgcn_fence(__ATOMIC_ACQUIRE, "agent");
            asm volatile("s_waitcnt vmcnt(0)" ::: "memory");
        }
    }
    __syncthreads();
}
constexpr int MERGE_ITEMS = SEQ * 128, MERGE_SPLIT = (MERGE_ITEMS / 16) * 7;
constexpr int LDS_XB = LDS_BYTES - 16;

__global__ void __launch_bounds__(NTHR) hybrid_encoder_fwd(Params P) {
    extern __shared__ __attribute__((aligned(16))) unsigned char lds_raw[];
    LAS unsigned char* lds = (LAS unsigned char*)lds_raw;
    cg::grid_group grid = cg::this_grid();
    if (threadIdx.x == 0) { *(volatile LAS unsigned*)(lds + LDS_XB) = 0u; *(volatile LAS unsigned*)(lds + LDS_XB + 4) = 0u; }
    __syncthreads();
    const XcdBarrier xb = xcd_barrier_post((unsigned*)P.ws, (volatile LAS unsigned*)(lds + LDS_XB));
    const int tid = threadIdx.x, lane = tid & 63, wid = __builtin_amdgcn_readfirstlane(tid >> 6);
    const int bid = blockIdx.x, G = gridDim.x;
    unsigned char* ws = P.ws;
    bf16_t* XG = (bf16_t*)(ws + WS_XG);
    bf16_t* Qb = (bf16_t*)(ws + WS_Q); bf16_t* Kb = (bf16_t*)(ws + WS_K); bf16_t* Vb = (bf16_t*)(ws + WS_V);
    bf16_t* U2 = (bf16_t*)(ws + WS_U2); float* Z = (float*)(ws + WS_Z); bf16_t* Y = (bf16_t*)(ws + WS_Y); bf16_t* MG = (bf16_t*)(ws + WS_MG);
    bf16_t* H = (bf16_t*)(ws + WS_H); float* NUM = (float*)(ws + WS_NUM); float* ML = (float*)(ws + WS_ML); float* SSQ = (float*)(ws + WS_SSQ);
#define GSYNC0() do { asm volatile("s_waitcnt vmcnt(0) lgkmcnt(0)" ::: "memory"); grid.sync(); } while (0)
#define GSYNC() xcd_barrier(xb)

    {
        {
            const float* x = P.in[0];
            for (int row = bid * 8 + wid; row < SEQ; row += G * 8) {
                float ss = 0.f;
#pragma unroll
                for (int i = 0; i < 8; ++i) { const int c = lane * 4 + 256 * i; const f32x4 v = *(const f32x4*)(x + (size_t)row * DM + c);
                    u32x2 w; w.x = cvt_pk_bf16(v[0], v[1]); w.y = cvt_pk_bf16(v[2], v[3]);
                    const float r0 = bf_lo(w.x), r1 = bf_hi(w.x), r2 = bf_lo(w.y), r3 = bf_hi(w.y); ss += (r0 * r0 + r1 * r1) + (r2 * r2 + r3 * r3);
                    *(u32x2*)(XG + (size_t)row * DM + c) = w; }
                ss += __shfl_xor(ss, 32);
                if (lane < 32) SSQ[(size_t)row * 32 + lane] = ss;
            }
        }
        for (int it = bid; it < 128; it += G) { s5_gen(lds, P, it >> 6, it & 63);
        }
        {
            constexpr int PB_PAIR = (T_PAIR - T_W2) / 4, NBATCH = 2 * PB_PAIR, NB1 = 7680;
#define PREP_TILE(bt) (((bt) / PB_PAIR) * T_PAIR + ((bt) % PB_PAIR) * 4)
            if (bid >= 128) for (int bt = (bid - 128) * 8 + wid; bt < NB1; bt += (G - 128) * 8) {
#pragma unroll 1
                for (int q = 0; q < 4; ++q) conv_dispatch(P, PREP_TILE(bt) + q, lane); }
            for (int bt = NB1 + bid * 8 + wid; bt < NBATCH; bt += G * 8) {
#pragma unroll 1
                for (int q = 0; q < 4; ++q) conv_dispatch(P, PREP_TILE(bt) + q, lane); }
#undef PREP_TILE
        }
    }
    GSYNC0();

    for (int layer = 0; layer < 4; ++layer) {
        const int j = layer >> 1; const bool odd = layer & 1;
        const float* ssq_mix = SSQ + (size_t)(2 * layer) * SEQ * 32; float* ssq_mlp = SSQ + (size_t)(2 * layer + 1) * SEQ * 32; float* ssq_nxt = SSQ + (size_t)(2 * layer + 2) * SEQ * 32;
        {
            Gemm gm; gm.A = XG; gm.Bt = odd ? (const bf16_t*)(ws + WS_QKV + j * SZ_QKV) : (const bf16_t*)(ws + WS_WIN + j * SZ_WIN); gm.lda = DM; gm.ldb = DM; gm.K = DM;
            StaticOrder S; S.init(SEQ, odd ? 6144 : 4096, G, bid);
            EpiIn E; E.Q = Qb; E.K = Kb; E.V = Vb; E.U2 = U2; E.ssq = ssq_mix; E.shift = odd ? 11 : 10; E.ldq = odd ? 2048 : 1024;
            gemm_phase<EpiIn, StaticOrder>(lds, gm, S, E);
        }
        GSYNC();
        if (!odd) {
            {
                Gemm gm; gm.A = U2; gm.Bt = (const bf16_t*)(ws + WS_B1 + j * SZ_B1); gm.lda = 768; gm.ldb = 512; gm.K = 512;
                ListOrder S; S.total = 64; S.G = 64; S.c = bid; S.mode = 0;
                EpiP1 E; E.Z = Z;
                gemm_phase<EpiP1, ListOrder>(lds, gm, S, E);
                if (bid < 64) {
                    asm volatile("s_waitcnt vmcnt(0)" ::: "memory"); __syncthreads();
                    __builtin_amdgcn_fence(__ATOMIC_ACQUIRE, "agent"); asm volatile("s_waitcnt vmcnt(0)" ::: "memory");
                    s5_carry2(P, j, bid);
                    asm volatile("s_waitcnt vmcnt(0)" ::: "memory"); __syncthreads();
                    __builtin_amdgcn_fence(__ATOMIC_ACQUIRE, "agent"); asm volatile("s_waitcnt vmcnt(0)" ::: "memory"); __syncthreads();
                    Gemm g3; g3.A = U2; g3.Bt = (const bf16_t*)(ws + WS_B3 + j * SZ_B3); g3.lda = 768; g3.ldb = 768; g3.K = 768;
                    ListOrder S3; S3.total = 128; S3.G = 64; S3.c = bid; S3.mode = 2;
                    EpiP3 E3; E3.Y = Y;
                    gemm_phase<EpiP3, ListOrder>(lds, g3, S3, E3);
                } else {
                    attn_a_phase(lds, bid - 64, 192, 8, Qb, Kb, Vb, P.in[1], NUM, ML);
                }
            }
            GSYNC();
            {
                Gemm gm; gm.A = Y; gm.Bt = (const bf16_t*)(ws + WS_GLU + j * SZ_GLU); gm.lda = 1024; gm.ldb = 1024; gm.K = 1024;
                StaticOrder S; S.init(SEQ, 1024, G, bid);
                EpiGlu E; E.Y = Y; E.MG = MG;
                gemm_phase<EpiGlu, StaticOrder>(lds, gm, S, E);
                if (bid >= 128) attn_a_merge(NUM, ML, MG, (bid - 128) * NTHR + tid, 128 * NTHR, 0, MERGE_ITEMS);
            }
            GSYNC();
        } else {
            attn_c_phase(lds, bid, G, Qb, Kb, Vb, P.in[15] + (size_t)j * 16 * 465, MG,
                         P.in[18] + (size_t)layer * 2048 * 8192, (bf16_t*)(ws + WS_W1 + layer * SZ_W1), P.in[19] + (size_t)layer * 8192 * 2048, (bf16_t*)(ws + WS_W2 + layer * SZ_W2), P.in[17] + (size_t)layer * DM);
            GSYNC();
        }
        {
            Gemm gm; gm.A = MG; gm.Bt = odd ? (const bf16_t*)(ws + WS_COUT + j * SZ_WOUT) : (const bf16_t*)(ws + WS_WOUT + j * SZ_WOUT); gm.lda = DM; gm.ldb = DM; gm.K = DM;
            StaticOrder S; S.init(SEQ, DM, G, bid);
            EpiRes E; E.XB = XG; E.ssq_next = ssq_mlp;
            gemm_phase<EpiRes, StaticOrder>(lds, gm, S, E);
        }
        GSYNC();
        {
            Gemm gm; gm.A = XG; gm.Bt = (const bf16_t*)(ws + WS_W1 + layer * SZ_W1); gm.lda = DM; gm.ldb = DM; gm.K = DM;
            StaticOrder S; S.init(SEQ, DFF, G, bid);
            EpiH E; E.H = H; E.ssq = ssq_mlp;
            gemm_phase<EpiH, StaticOrder>(lds, gm, S, E);
        }
        GSYNC();
        {
            Gemm gm; gm.A = H; gm.Bt = (const bf16_t*)(ws + WS_W2 + layer * SZ_W2); gm.lda = DFF; gm.ldb = DFF; gm.K = DFF;
            StaticOrder S; S.init(SEQ, DM, G, bid);
            EpiRes E; E.XB = XG; E.ssq_next = ssq_nxt;
            gemm_phase<EpiRes, StaticOrder>(lds, gm, S, E);
        }
        GSYNC();
    }
    {
        const float* ssq = SSQ + (size_t)8 * SEQ * 32; const float* gf = P.in[20];
        for (int row = bid * 8 + wid; row < SEQ; row += G * 8) {
            const float rs = row_rstd(ssq, row);
#pragma unroll
            for (int i = 0; i < 8; ++i) { const int c = lane * 4 + 256 * i;
                const u32x2 xw = *(const u32x2*)(XG + (size_t)row * DM + c); const f32x4 gv = *(const f32x4*)(gf + c);
                f32x4 v; v[0] = bf_lo(xw.x); v[1] = bf_hi(xw.x); v[2] = bf_lo(xw.y); v[3] = bf_hi(xw.y);
                *(f32x4*)(P.out + (size_t)row * DM + c) = v * rs * gv; }
        }
    }
}

extern "C" void kernel_launch(void* const* d_in, const int* in_sizes, int n_in, void* d_out, int out_size, void* d_ws, size_t ws_size, hipStream_t stream) {
    static int grid = 0;
    if (grid == 0) {
        if (n_in != 21 || ws_size < WS_END) { fprintf(stderr, "kernel_launch: need 21 inputs and %zu bytes of workspace (got %d, %zu)\n", (size_t)WS_END, n_in, ws_size); grid = -1; return; }
        int dev = 0, cus = 0, per_cu = 0;
        hipGetDevice(&dev); hipDeviceGetAttribute(&cus, hipDeviceAttributeMultiprocessorCount, dev);
        if (hipFuncSetAttribute((const void*)hybrid_encoder_fwd, hipFuncAttributeMaxDynamicSharedMemorySize, LDS_BYTES) != hipSuccess) { fprintf(stderr, "kernel_launch: hipFuncSetAttribute failed\n"); grid = -1; return; }
        if (hipOccupancyMaxActiveBlocksPerMultiprocessor(&per_cu, (const void*)hybrid_encoder_fwd, NTHR, LDS_BYTES) != hipSuccess || per_cu < 1) { fprintf(stderr, "kernel_launch: occupancy query says %d blocks/CU\n", per_cu); per_cu = 1; }
        (void)hipGetLastError();
        grid = cus;
    }
    if (grid < 0) return;
    hipMemsetAsync((char*)d_ws + WS_CTRL, 0, 16384, stream);
    Params p{};
    for (int i = 0; i < 21; ++i) p.in[i] = (const float*)d_in[i];
    p.out = (float*)d_out; p.ws = (unsigned char*)d_ws; p.coop = 1; p.pad = 0;
    void* args[] = {&p};
    hipError_t e = hipLaunchCooperativeKernel((const void*)hybrid_encoder_fwd, dim3(grid), dim3(NTHR), args, LDS_BYTES, stream);
    if (e != hipSuccess) fprintf(stderr, "cooperative launch failed: %s (grid %d)\n", hipGetErrorString(e), grid);
}
```

```cpp
#include <hip/hip_runtime.h>
#include <hip/hip_cooperative_groups.h>
#include <cstdio>
namespace cg = cooperative_groups;

#define LAS __attribute__((address_space(3)))
typedef unsigned short bf16_t;
typedef short bf16x8 __attribute__((ext_vector_type(8)));
typedef short s16x4 __attribute__((ext_vector_type(4)));
typedef float f32x4 __attribute__((ext_vector_type(4)));
typedef float f32x2 __attribute__((ext_vector_type(2)));
typedef unsigned u32x4 __attribute__((ext_vector_type(4)));
typedef unsigned u32x2 __attribute__((ext_vector_type(2)));

constexpr int SEQ = 8192, DM = 2048, DFF = 8192;
constexpr float RMS_EPS = 1e-6f;
constexpr int NTHR = 512;

constexpr size_t SZ_WIN = (size_t)4096 * 2048 * 2, SZ_WOUT = (size_t)2048 * 2048 * 2, SZ_GLU = (size_t)1024 * 1024 * 2;
constexpr size_t SZ_QKV = (size_t)6144 * 2048 * 2, SZ_W1 = (size_t)8192 * 2048 * 2, SZ_W2 = SZ_W1;
constexpr size_t SZ_B3 = (size_t)64 * 512 * 768 * 2, SZ_B1 = (size_t)64 * 256 * 512 * 2;
constexpr size_t WS_CTRL = 0;
constexpr size_t WS_WIN = 16384;
constexpr size_t WS_WOUT = WS_WIN + 2 * SZ_WIN;
constexpr size_t WS_GLU = WS_WOUT + 2 * SZ_WOUT;
constexpr size_t WS_QKV = WS_GLU + 2 * SZ_GLU;
constexpr size_t WS_COUT = WS_QKV + 2 * SZ_QKV;
constexpr size_t WS_W1 = WS_COUT + 2 * SZ_WOUT;
constexpr size_t WS_W2 = WS_W1 + 4 * SZ_W1;
constexpr size_t WS_B3 = WS_W2 + 4 * SZ_W2;
constexpr size_t WS_B1 = WS_B3 + 2 * SZ_B3;
constexpr size_t WS_X = WS_B1 + 2 * SZ_B1;
constexpr size_t WS_XG = WS_X + (size_t)SEQ * DM * 4;
constexpr size_t WS_Q = WS_XG + (size_t)SEQ * DM * 2;
constexpr size_t WS_K = WS_Q + (size_t)SEQ * DM * 2;
constexpr size_t WS_V = WS_K + (size_t)SEQ * DM * 2;
constexpr size_t WS_U2 = WS_V + (size_t)SEQ * DM * 2;
constexpr size_t WS_Z = WS_U2 + (size_t)64 * 256 * 768 * 2;
constexpr size_t WS_Y = WS_Z + (size_t)64 * 256 * 256 * 4;
constexpr size_t WS_MG = WS_Y + (size_t)SEQ * 1024 * 2;
constexpr size_t WS_H = WS_MG + (size_t)SEQ * DM * 2;
constexpr size_t WS_NUM = WS_H;
constexpr size_t WS_ML = WS_H + (size_t)SEQ * DFF * 2;
constexpr size_t WS_SSQ = WS_ML + (size_t)3 * 8 * SEQ * 8;
constexpr size_t WS_A32 = WS_SSQ + (size_t)9 * SEQ * 32 * 4;
constexpr size_t WS_END = WS_A32 + (size_t)2 * 2 * 64 * 64 * 8;

struct Params { const float* in[21]; float* out; unsigned char* ws; int coop; int pad; };

__device__ __forceinline__ unsigned cvt_pk_bf16(float lo, float hi) { unsigned r; asm volatile("v_cvt_pk_bf16_f32 %0, %1, %2" : "=v"(r) : "v"(lo), "v"(hi)); return r; }
__device__ __forceinline__ unsigned cvt_pk_bf16_t(float lo, float hi) { unsigned r; asm volatile("s_nop 1\n\tv_cvt_pk_bf16_f32 %0, %1, %2" : "=v"(r) : "v"(lo), "v"(hi)); return r; }
__device__ __forceinline__ unsigned cvt_pk_sw(float lo, float hi) { unsigned a = __float_as_uint(lo), b = __float_as_uint(hi); a += 0x7fffu + ((a >> 16) & 1u); b += 0x7fffu + ((b >> 16) & 1u); return (a >> 16) | (b & 0xffff0000u); }
__device__ __forceinline__ float bf_lo(unsigned w) { return __uint_as_float(w << 16); }
__device__ __forceinline__ float bf_hi(unsigned w) { return __uint_as_float(w & 0xffff0000u); }

__device__ __forceinline__ float row_rstd(const float* ssqp, int row) {
    const f32x4* p = (const f32x4*)(ssqp + (size_t)row * 32); f32x4 a = p[0];
#pragma unroll
    for (int i = 1; i < 8; ++i) a += p[i];
    return rsqrtf(((a[0] + a[1]) + (a[2] + a[3])) * (1.0f / DM) + RMS_EPS);
}
constexpr int BM = 256, BK = 64, HALF = 128, HTB = HALF * BK * 2, STAGE_BYTES = 8 * HTB, NXCD = 8, WGM = 8;
__device__ __forceinline__ int lds_byte(int r, int c) { const int st = (r >> 4) * 2 + (c >> 5), rr = r & 15, cc = c & 31, ob = rr * 64 + cc * 2; return st * 1024 + (ob ^ (((ob >> 9) & 1) << 5)); }
__device__ __forceinline__ void stage_rc(int b, int& R, int& C) { const int st = b / 1024, sb = b % 1024, swz = sb ^ (((sb >> 9) & 1) << 5); R = (st >> 1) * 16 + swz / 64; C = (st & 1) * 32 + (swz % 64) / 2; }
__device__ __forceinline__ int perm32(int rho) { const int n = rho >> 4, i = rho & 15; return 8 * (i >> 2) + 4 * n + (i & 3); }

struct Unit { int pm, pn; };
struct Gemm { const bf16_t* A; const bf16_t* Bt; int lda, ldb, K; };

struct StaticOrder {
    int nM, nN, nwg, G, c;
    __device__ void init(int M, int N, int G_, int c_) { nM = M / BM; nN = N / BM; nwg = nM * nN; G = G_; c = c_; }
    __device__ bool next(int i, Unit& u) const {
        const long L = (long)i * G + c; if (L >= nwg) return false;
        int wgid = (int)L; { const int q = nwg / NXCD, r = nwg % NXCD, xcd = wgid % NXCD, off = wgid / NXCD; wgid = (xcd < r ? xcd * (q + 1) : r * (q + 1) + (xcd - r) * q) + off; }
        const int nig = WGM * nN, gid = wgid / nig, fm = gid * WGM, gsz = (nM - fm) < WGM ? (nM - fm) : WGM;
        u.pm = fm + ((wgid % nig) % gsz); u.pn = (wgid % nig) / gsz; return true;
    }
};
struct ListOrder {
    int total, G, c, mode;
    __device__ bool next(int i, Unit& u) const {
        if (mode == 2) { if (c >= G || i >= 2) return false; u.pm = c; u.pn = 2 * c + i; return true; }
        const int L = i * G + c; if (c >= G || L >= total) return false; if (mode == 0) { u.pm = L; u.pn = L; } else { u.pm = L >> 1; u.pn = L; } return true; }
};


struct EpiIn {
    static constexpr bool PERM = true, NEEDS_RSTD = true;
    bf16_t* Q; bf16_t* K; bf16_t* V; bf16_t* U2; const float* ssq; int shift, ldq;
    __device__ __forceinline__ void operator()(const f32x4 (&acc)[2][2][4][2], const Unit& u, int ui, const LAS float* rtab, int wr, int wc, int fr, int fq) const {
        const int row0 = u.pm * BM + wr * 64 + fr; const int colt = u.pn * BM; const int t = colt >> shift; const int lc0 = (colt & ((1 << shift) - 1)) + wc * 32 + 8 * fq;
        bf16_t* base = (t == 0) ? Q : ((t == 1) ? K : V);
#pragma unroll
        for (int ai = 0; ai < 2; ++ai)
#pragma unroll
            for (int m = 0; m < 4; ++m) {
                const int row = row0 + ai * HALF + m * 16; const float rs = rtab[ui * 256 + wr * 64 + fr + ai * HALF + m * 16];
#pragma unroll
                for (int bj = 0; bj < 2; ++bj) {
                    const int lc = lc0 + bj * HALF; const f32x4 v0 = acc[ai][bj][m][0] * rs, v1 = acc[ai][bj][m][1] * rs;
                    u32x4 w; w.x = cvt_pk_bf16(v0[0], v0[1]); w.y = cvt_pk_bf16(v0[2], v0[3]); w.z = cvt_pk_bf16(v1[0], v1[1]); w.w = cvt_pk_bf16(v1[2], v1[3]);
                    if (t < 3) *(u32x4*)(base + (size_t)row * ldq + lc) = w;
                    else { const int g = lc >> 4, c = lc & 15, n = row >> 5, tt = row & 31; *(u32x4*)(U2 + ((size_t)(g * 256 + n) * 768 + tt * 16 + c)) = w; }
                }
            }
    }
};
struct EpiRes {
    static constexpr bool PERM = true, NEEDS_RSTD = false;
    bf16_t* XB; float* ssq_next;
    __device__ __forceinline__ void operator()(const f32x4 (&acc)[2][2][4][2], const Unit& u, int ui, const LAS float* rtab, int wr, int wc, int fr, int fq) const {
        const int row0 = u.pm * BM + wr * 64 + fr, col0 = u.pn * BM + wc * 32 + 8 * fq;
#pragma unroll
        for (int ai = 0; ai < 2; ++ai) {
            u32x4 xv[4][2];
#pragma unroll
            for (int m = 0; m < 4; ++m)
#pragma unroll
                for (int bj = 0; bj < 2; ++bj) xv[m][bj] = *(const u32x4*)(XB + (size_t)(row0 + ai * HALF + m * 16) * DM + col0 + bj * HALF);
#pragma unroll
            for (int m = 0; m < 4; ++m) { const int row = row0 + ai * HALF + m * 16; float ss = 0.f;
#pragma unroll
                for (int bj = 0; bj < 2; ++bj) {
                    const f32x4 a0 = acc[ai][bj][m][0], a1 = acc[ai][bj][m][1]; const u32x4 xo = xv[m][bj]; u32x4 w;
                    w.x = cvt_pk_bf16(bf_lo(xo.x) + a0[0], bf_hi(xo.x) + a0[1]); w.y = cvt_pk_bf16(bf_lo(xo.y) + a0[2], bf_hi(xo.y) + a0[3]);
                    w.z = cvt_pk_bf16(bf_lo(xo.z) + a1[0], bf_hi(xo.z) + a1[1]); w.w = cvt_pk_bf16(bf_lo(xo.w) + a1[2], bf_hi(xo.w) + a1[3]);
                    *(u32x4*)(XB + (size_t)row * DM + col0 + bj * HALF) = w;
#pragma unroll
                    for (int e = 0; e < 4; ++e) { const float lo = bf_lo(w[e]), hi = bf_hi(w[e]); ss += lo * lo + hi * hi; }
                }
                ss += __shfl_xor(ss, 16); ss += __shfl_xor(ss, 32);
                if (fq == 0) ssq_next[(size_t)row * 32 + (u.pn & 7) * 4 + wc] = ss; }
        }
    }
};
struct EpiH {
    static constexpr bool PERM = true, NEEDS_RSTD = true;
    bf16_t* H; const float* ssq;
    __device__ __forceinline__ void operator()(const f32x4 (&acc)[2][2][4][2], const Unit& u, int ui, const LAS float* rtab, int wr, int wc, int fr, int fq) const {
        const int row0 = u.pm * BM + wr * 64 + fr, col0 = u.pn * BM + wc * 32 + 8 * fq;
#pragma unroll
        for (int ai = 0; ai < 2; ++ai)
#pragma unroll
            for (int m = 0; m < 4; ++m) {
                const int row = row0 + ai * HALF + m * 16; const float rs = rtab[ui * 256 + wr * 64 + fr + ai * HALF + m * 16];
#pragma unroll
                for (int bj = 0; bj < 2; ++bj) {
                    f32x4 v0 = acc[ai][bj][m][0] * rs, v1 = acc[ai][bj][m][1] * rs;
#pragma unroll
                    for (int e = 0; e < 4; ++e) { const float a = fmaxf(v0[e], 0.f), b = fmaxf(v1[e], 0.f); v0[e] = a * a; v1[e] = b * b; }
                    u32x4 w; w.x = cvt_pk_bf16(v0[0], v0[1]); w.y = cvt_pk_bf16(v0[2], v0[3]); w.z = cvt_pk_bf16(v1[0], v1[1]); w.w = cvt_pk_bf16(v1[2], v1[3]);
                    *(u32x4*)(H + (size_t)row * DFF + col0 + bj * HALF) = w;
                }
            }
    }
};
struct EpiGlu {
    static constexpr bool PERM = true, NEEDS_RSTD = false;
    const bf16_t* Y; bf16_t* MG;
    __device__ __forceinline__ void operator()(const f32x4 (&acc)[2][2][4][2], const Unit& u, int ui, const LAS float* rtab, int wr, int wc, int fr, int fq) const {
        const int row0 = u.pm * BM + wr * 64 + fr, col0 = u.pn * BM + wc * 32 + 8 * fq;
#pragma unroll
        for (int ai = 0; ai < 2; ++ai)
#pragma unroll
            for (int m = 0; m < 4; ++m) {
                const int row = row0 + ai * HALF + m * 16;
#pragma unroll
                for (int bj = 0; bj < 2; ++bj) {
                    const int col = col0 + bj * HALF; const u32x4 yv = *(const u32x4*)(Y + (size_t)row * 1024 + col);
                    const f32x4 a0 = acc[ai][bj][m][0], a1 = acc[ai][bj][m][1]; float o[8];
                    const float yy[8] = {bf_lo(yv.x), bf_hi(yv.x), bf_lo(yv.y), bf_hi(yv.y), bf_lo(yv.z), bf_hi(yv.z), bf_lo(yv.w), bf_hi(yv.w)};
#pragma unroll
                    for (int e = 0; e < 4; ++e) { o[e] = yy[e] / (1.0f + __expf(-a0[e])); o[4 + e] = yy[4 + e] / (1.0f + __expf(-a1[e])); }
                    u32x4 w; w.x = cvt_pk_bf16(o[0], o[1]); w.y = cvt_pk_bf16(o[2], o[3]); w.z = cvt_pk_bf16(o[4], o[5]); w.w = cvt_pk_bf16(o[6], o[7]);
                    *(u32x4*)(MG + (size_t)row * DM + 1024 + col) = w;
                }
            }
    }
};
struct EpiP1 {
    static constexpr bool PERM = false, NEEDS_RSTD = false;
    float* Z;
    __device__ __forceinline__ void operator()(const f32x4 (&acc)[2][2][4][2], const Unit& u, int ui, const LAS float* rtab, int wr, int wc, int fr, int fq) const {
        const int row0 = u.pm * BM + wr * 64 + fr, col0 = wc * 32 + 4 * fq;
#pragma unroll
        for (int ai = 0; ai < 2; ++ai)
#pragma unroll
            for (int m = 0; m < 4; ++m) { float* rowp = Z + (size_t)(row0 + ai * HALF + m * 16) * 256 + col0;
#pragma unroll
                for (int bj = 0; bj < 2; ++bj)
#pragma unroll
                    for (int n = 0; n < 2; ++n) *(f32x4*)(rowp + bj * HALF + n * 16) = acc[ai][bj][m][n]; }
    }
};
__device__ __forceinline__ float gelu_tanh(float x) { const float z = 0.7978845608f * (x + 0.044715f * x * x * x); const float th = 1.0f - 2.0f / (__expf(2.0f * z) + 1.0f); return 0.5f * x * (1.0f + th); }
struct EpiP3 {
    static constexpr bool PERM = true, NEEDS_RSTD = false;
    bf16_t* Y;
    __device__ __forceinline__ void operator()(const f32x4 (&acc)[2][2][4][2], const Unit& u, int ui, const LAS float* rtab, int wr, int wc, int fr, int fq) const {
        const int g = u.pm; const int n0 = wr * 64 + fr; const int lc0 = (u.pn & 1) * 256 + wc * 32 + 8 * fq;
#pragma unroll
        for (int ai = 0; ai < 2; ++ai)
#pragma unroll
            for (int m = 0; m < 4; ++m) {
                const int n = n0 + ai * HALF + m * 16;
#pragma unroll
                for (int bj = 0; bj < 2; ++bj) {
                    const int lc = lc0 + bj * HALF, t = lc >> 4, co = lc & 15; const int token = n * 32 + t;
                    const f32x4 a0 = acc[ai][bj][m][0], a1 = acc[ai][bj][m][1];
                    u32x4 w; w.x = cvt_pk_bf16(gelu_tanh(a0[0]), gelu_tanh(a0[1])); w.y = cvt_pk_bf16(gelu_tanh(a0[2]), gelu_tanh(a0[3]));
                    w.z = cvt_pk_bf16(gelu_tanh(a1[0]), gelu_tanh(a1[1])); w.w = cvt_pk_bf16(gelu_tanh(a1[2]), gelu_tanh(a1[3]));
                    *(u32x4*)(Y + (size_t)token * 1024 + 16 * g + co) = w;
                }
            }
    }
};

template <class Epi, class Sched>
__device__ __forceinline__ void gemm_phase(LAS unsigned char* lds, const Gemm g, const Sched& S, const Epi& E) {
    int tid = threadIdx.x; asm volatile("" : "+v"(tid));
    const int wid = __builtin_amdgcn_readfirstlane(tid >> 6), lane = tid & 63, wr = wid >> 2, wc = wid & 3, fr = lane & 15, fq = lane >> 4;
    const int K = g.K, nt = K / BK;
    unsigned voffA[2], voffB[2];
#pragma unroll
    for (int i = 0; i < 2; ++i) { int R, C; stage_rc(tid * 16 + i * 8192, R, C); const int Rb = Epi::PERM ? ((R & ~31) + perm32(R & 31)) : R;
        voffA[i] = (unsigned)(R * g.lda + C) * 2u; voffB[i] = (unsigned)(Rb * g.ldb + C) * 2u; }
    const size_t kstep = (size_t)(BK * 2);
    const size_t hstepA = (size_t)HALF * g.lda * 2, hstepB = (size_t)HALF * g.ldb * 2;
    const size_t tstepA = 2 * hstepA, tstepB = 2 * hstepB;
    const unsigned ldsw = (unsigned)wid * 1024u;
    const int aoff = lds_byte(wr * 64 + fr, fq * 8), boff = lds_byte(wc * 32 + fr, fq * 8);
#define PG8_SA(b, h) (((b) * 2 + (h)) * HTB)
#define PG8_SB(b, h) ((4 + (b) * 2 + (h)) * HTB)
#define PG8_STAGE(bufoff, gbase, voff) do { _Pragma("unroll") for (int _i = 0; _i < 2; ++_i) \
        __builtin_amdgcn_global_load_lds((const unsigned*)((const char*)(gbase) + (voff)[_i]), (LAS unsigned*)(lds + (bufoff) + ldsw + _i * 8192), 16, 0, 0); } while (0)
#define PG8_LDA(dst, b, h) do { _Pragma("unroll") for (int m = 0; m < 4; ++m) _Pragma("unroll") for (int k = 0; k < 2; ++k) dst[m][k] = *(const LAS bf16x8*)(lds + PG8_SA(b, h) + aoff + m * 2048 + k * 1024); } while (0)
#define PG8_LDB(dst, b, h) do { _Pragma("unroll") for (int n = 0; n < 2; ++n) _Pragma("unroll") for (int k = 0; k < 2; ++k) dst[n][k] = *(const LAS bf16x8*)(lds + PG8_SB(b, h) + boff + n * 2048 + k * 1024); } while (0)
#define PG8_MMA(ai, bj, At, Bt) do { __builtin_amdgcn_s_setprio(1); _Pragma("unroll") for (int m = 0; m < 4; ++m) _Pragma("unroll") for (int n = 0; n < 2; ++n) _Pragma("unroll") for (int k = 0; k < 2; ++k) \
        acc[ai][bj][m][n] = __builtin_amdgcn_mfma_f32_16x16x32_bf16(Bt[n][k], At[m][k], acc[ai][bj][m][n], 0, 0, 0); __builtin_amdgcn_s_setprio(0); } while (0)
#define PG8_WAIT_V(n) asm volatile("s_waitcnt vmcnt(" #n ")" ::: "memory")
#define PG8_WAIT_L(n) asm volatile("s_waitcnt lgkmcnt(" #n ")" ::: "memory")
#define PG8_BAR __builtin_amdgcn_s_barrier()
#define PG8_SCHED __builtin_amdgcn_sched_barrier(0)
    Unit cur, nxt; int ui = 0;
    if (!S.next(0, cur)) return;

    f32x4 acc[2][2][4][2];
#pragma unroll
    for (int a = 0; a < 2; ++a)
#pragma unroll
        for (int b = 0; b < 2; ++b)
#pragma unroll
            for (int m = 0; m < 4; ++m)
#pragma unroll
                for (int n = 0; n < 2; ++n) acc[a][b][m][n] = (f32x4){0.f, 0.f, 0.f, 0.f};
    bf16x8 At[4][2], B0[2][2], B1[2][2];
    const char* cA = (const char*)g.A + (size_t)cur.pm * tstepA; const char* cB = (const char*)g.Bt + (size_t)cur.pn * tstepB;
    PG8_STAGE(PG8_SB(0, 0), cB, voffB); PG8_STAGE(PG8_SA(0, 0), cA, voffA); PG8_STAGE(PG8_SB(0, 1), cB + hstepB, voffB); PG8_STAGE(PG8_SA(0, 1), cA + hstepA, voffA);
    if constexpr (Epi::NEEDS_RSTD) {
        LAS float* rt = (LAS float*)(lds + STAGE_BYTES);
        for (int i = tid >> 8; i < 4; i += 2) { Unit uu; if (!S.next(i, uu)) break; rt[i * 256 + (tid & 255)] = row_rstd(E.ssq, uu.pm * BM + (tid & 255)); }
        __syncthreads();
    }
    if (wr == 1) PG8_BAR;
    PG8_WAIT_V(4); PG8_BAR;
    PG8_STAGE(PG8_SB(1, 0), cB + kstep, voffB); PG8_STAGE(PG8_SA(1, 0), cA + kstep, voffA); PG8_STAGE(PG8_SB(1, 1), cB + hstepB + kstep, voffB);
    PG8_WAIT_V(6); PG8_BAR;
    for (;;) {
        const bool has_next = S.next(ui + 1, nxt);
        const char* nA = has_next ? (const char*)g.A + (size_t)nxt.pm * tstepA : cA; const char* nB = has_next ? (const char*)g.Bt + (size_t)nxt.pn * tstepB : cB;
        for (int t = 0; t < nt; t += 2) {
            const bool last = (t == nt - 2);
            const char* a1 = cA + (size_t)(t + 1) * kstep;
            const char* a2 = last ? nA : cA + (size_t)(t + 2) * kstep; const char* b2 = last ? nB : cB + (size_t)(t + 2) * kstep;
            const char* a3 = a2 + kstep; const char* b3 = b2 + kstep;
            PG8_LDB(B0, 0, 0); PG8_SCHED; PG8_LDA(At, 0, 0); PG8_STAGE(PG8_SA(1, 1), a1 + hstepA, voffA);
            PG8_WAIT_L(8); PG8_BAR; PG8_WAIT_L(0); PG8_MMA(0, 0, At, B0); PG8_BAR; PG8_SCHED;
            PG8_LDB(B1, 0, 1); PG8_STAGE(PG8_SB(0, 0), b2, voffB);
            PG8_BAR; PG8_WAIT_L(0); PG8_MMA(0, 1, At, B1); PG8_BAR;
            PG8_LDA(At, 0, 1); PG8_STAGE(PG8_SA(0, 0), a2, voffA);
            PG8_BAR; PG8_WAIT_L(0); PG8_MMA(1, 0, At, B0); PG8_BAR; PG8_SCHED;
            PG8_STAGE(PG8_SB(0, 1), b2 + hstepB, voffB);
            PG8_WAIT_V(6); PG8_BAR; PG8_MMA(1, 1, At, B1); PG8_BAR;
            PG8_LDB(B0, 1, 0); PG8_SCHED; PG8_LDA(At, 1, 0); PG8_STAGE(PG8_SA(0, 1), a2 + hstepA, voffA);
            PG8_WAIT_L(8); PG8_BAR; PG8_WAIT_L(0); PG8_MMA(0, 0, At, B0); PG8_BAR; PG8_SCHED;
            PG8_LDB(B1, 1, 1); PG8_STAGE(PG8_SB(1, 0), b3, voffB);
            PG8_BAR; PG8_WAIT_L(0); PG8_MMA(0, 1, At, B1); PG8_BAR;
            PG8_LDA(At, 1, 1); PG8_STAGE(PG8_SA(1, 0), a3, voffA);
            PG8_BAR; PG8_WAIT_L(0); PG8_MMA(1, 0, At, B0); PG8_BAR; PG8_SCHED;
            PG8_STAGE(PG8_SB(1, 1), b3 + hstepB, voffB);
            PG8_WAIT_V(6); PG8_BAR; PG8_MMA(1, 1, At, B1); PG8_BAR;
        }
        E(acc, cur, ui, (const LAS float*)(lds + STAGE_BYTES), wr, wc, fr, fq);
        if (!has_next) break;
#pragma unroll
        for (int a = 0; a < 2; ++a)
#pragma unroll
            for (int b = 0; b < 2; ++b)
#pragma unroll
                for (int m = 0; m < 4; ++m)
#pragma unroll
                    for (int n = 0; n < 2; ++n) acc[a][b][m][n] = (f32x4){0.f, 0.f, 0.f, 0.f};
        cur = nxt; cA = nA; cB = nB; ++ui;
    }
    PG8_WAIT_V(0);
    if (wr == 0) PG8_BAR;
    PG8_BAR;
#undef PG8_SA
#undef PG8_SB
#undef PG8_STAGE
#undef PG8_LDA
#undef PG8_LDB
#undef PG8_MMA
#undef PG8_WAIT_V
#undef PG8_WAIT_L
#undef PG8_BAR
#undef PG8_SCHED
}

__device__ __forceinline__ void conv_issue(const float* src, int N, int tile, int lane, f32x4 (&v)[8]) {
    const int tn = N >> 5; const int k0 = (tile / tn) * 64, n0 = (tile % tn) * 32; const int kg = lane & 7, jn = lane >> 3;
    const float* sp = src + (size_t)(k0 + 8 * kg) * N + n0 + 4 * jn;
#pragma unroll
    for (int r = 0; r < 8; ++r) v[r] = *(const f32x4*)(sp + (size_t)r * N);
}
__device__ __forceinline__ void conv_finish(bf16_t* dst, int K, int N, int tile, int lane, f32x4 (&v)[8], const float* gk) {
    const int tn = N >> 5; const int k0 = (tile / tn) * 64, n0 = (tile % tn) * 32; const int kg = lane & 7, jn = lane >> 3;
    if (gk) { const f32x4 g0 = *(const f32x4*)(gk + k0 + 8 * kg), g1 = *(const f32x4*)(gk + k0 + 8 * kg + 4);
#pragma unroll
        for (int r = 0; r < 4; ++r) { v[r] *= g0[r]; v[4 + r] *= g1[r]; } }
#pragma unroll
    for (int i = 0; i < 4; ++i) { u32x4 w; w.x = cvt_pk_bf16(v[0][i], v[1][i]); w.y = cvt_pk_bf16(v[2][i], v[3][i]); w.z = cvt_pk_bf16(v[4][i], v[5][i]); w.w = cvt_pk_bf16(v[6][i], v[7][i]);
        *(u32x4*)(dst + (size_t)(n0 + 4 * jn + i) * K + k0 + 8 * kg) = w; }
}
constexpr int KSTR = 272, VSTR = 288, AROWS = 272;
constexpr int LDSA_K = 0, LDSA_V = AROWS * KSTR, LDS_TAB = LDSA_V + AROWS * VSTR;
constexpr int LDSC_V = 0, LDSC_K = 192 * VSTR;
constexpr int LDS_BYTES = LDS_TAB + 2048;

constexpr float LOG2E = 1.4426950408889634f, LN2 = 0.6931471805599453f, DEFER_THR = 11.0f;
typedef short v4i16_t __attribute__((ext_vector_type(4)));
__device__ __forceinline__ s16x4 tr_read(LAS const unsigned char* p) { return __builtin_bit_cast(s16x4, __builtin_amdgcn_ds_read_tr16_b64_v4i16((LAS v4i16_t*)p)); }

__device__ __forceinline__ void store_o_rows(bf16_t* rowp, const f32x4 (&O)[8], float inv, int g) {
    bf16_t* p = rowp + 4 * (g & ~1) + 16 * (g & 1);
#pragma unroll
    for (int k = 0; k < 4; ++k) {
        const f32x4 e = O[2 * k] * inv, o = O[2 * k + 1] * inv;
        const unsigned e0 = cvt_pk_bf16(e[0], e[1]), e1 = cvt_pk_bf16(e[2], e[3]), o0 = cvt_pk_bf16(o[0], o[1]), o1 = cvt_pk_bf16(o[2], o[3]);
        auto r0 = __builtin_amdgcn_permlane16_swap(e0, o0, false, false);
        auto r1 = __builtin_amdgcn_permlane16_swap(e1, o1, false, false);
        u32x4 w; w.x = r0[0]; w.y = r1[0]; w.z = r0[1]; w.w = r1[1];
        *(u32x4*)(p + 32 * k) = w;
    }
}
template <int LDS_K>
__device__ __forceinline__ void attn_qk(LAS const unsigned char* lds, int rowa, int rowb, const bf16x8 (&qf)[4], int lane, f32x4& sa, f32x4& sb) {
    const int fr = lane & 15, g = lane >> 4;
    sa = (f32x4){0.f, 0.f, 0.f, 0.f}; sb = sa;
    LAS const unsigned char* pa = lds + LDS_K + (rowa + fr) * KSTR + g * 16;
    LAS const unsigned char* pb = lds + LDS_K + (rowb + fr) * KSTR + g * 16;
#pragma unroll
    for (int s = 0; s < 4; ++s) {
        const bf16x8 ka = *(const LAS bf16x8*)(pa + s * 64), kb = *(const LAS bf16x8*)(pb + s * 64);
        sa = __builtin_amdgcn_mfma_f32_16x16x32_bf16(ka, qf[s], sa, 0, 0, 0);
        sb = __builtin_amdgcn_mfma_f32_16x16x32_bf16(kb, qf[s], sb, 0, 0, 0);
    }
}
template <int LDS_V>
__device__ __forceinline__ void attn_pv(LAS const unsigned char* lds, int rowa, int rowb, const f32x4 sa, const f32x4 sb, f32x4 (&O)[8], float& m_run, float& l_run, int lane) {
    const int g = lane >> 4, ii = lane & 15;
    float mx = fmaxf(fmaxf(fmaxf(sa[0], sa[1]), fmaxf(sa[2], sa[3])), fmaxf(fmaxf(sb[0], sb[1]), fmaxf(sb[2], sb[3])));
    if (__builtin_amdgcn_ballot_w64(mx > m_run + DEFER_THR) != 0ull) {
        mx = fmaxf(mx, __shfl_xor(mx, 16)); mx = fmaxf(mx, __shfl_xor(mx, 32));
        const float m_new = fmaxf(m_run, mx);
        const float alpha = __builtin_amdgcn_exp2f(m_run - m_new);
        l_run *= alpha; m_run = m_new;
#pragma unroll
        for (int cb = 0; cb < 8; ++cb) O[cb] *= alpha;
    }
    float pa[4], pb[4]; float sum = 0.f;
#pragma unroll
    for (int j = 0; j < 4; ++j) { pa[j] = __builtin_amdgcn_exp2f(sa[j] - m_run); pb[j] = __builtin_amdgcn_exp2f(sb[j] - m_run); sum += pa[j] + pb[j]; }
    l_run += sum;
    u32x4 pw; pw.x = cvt_pk_bf16_t(pa[0], pa[1]); pw.y = cvt_pk_bf16_t(pa[2], pa[3]); pw.z = cvt_pk_bf16_t(pb[0], pb[1]); pw.w = cvt_pk_bf16_t(pb[2], pb[3]);
    const bf16x8 pf = __builtin_bit_cast(bf16x8, pw);
    LAS const unsigned char* va = lds + LDS_V + (rowa + 4 * g + (ii >> 2)) * VSTR + (ii & 3) * 8;
    LAS const unsigned char* vb = lds + LDS_V + (rowb + 4 * g + (ii >> 2)) * VSTR + (ii & 3) * 8;
#pragma unroll
    for (int cb = 0; cb < 8; ++cb) {
        const s16x4 lo = tr_read(va + cb * 32), hi = tr_read(vb + cb * 32);
        bf16x8 vf; vf[0] = lo[0]; vf[1] = lo[1]; vf[2] = lo[2]; vf[3] = lo[3]; vf[4] = hi[0]; vf[5] = hi[1]; vf[6] = hi[2]; vf[7] = hi[3];
        O[cb] = __builtin_amdgcn_mfma_f32_16x16x32_bf16(vf, pf, O[cb], 0, 0, 0);
    }
}

struct AItem { int bi, h, b, d, r, nb, L; };
__device__ __forceinline__ AItem a_decode(int item) { AItem a; a.bi = item & 63; a.h = (item >> 6) & 7; a.b = item >> 9; const int sh = 2 * a.b; a.d = 1 << sh; a.r = a.bi & (a.d - 1); a.nb = a.bi >> sh; a.L = SEQ >> sh; return a; }
__device__ __forceinline__ void a_load(int item, int tid, const bf16_t* Kb, const bf16_t* Vb, u32x4 (&kv)[8], u32x4 (&vv)[8]) {
    const AItem a = a_decode(item);
#pragma unroll
    for (int it = 0; it < 8; ++it) {
        const int cid = tid + NTHR * it, row = cid >> 4, ch = cid & 15; const int l = a.nb * 128 + row - 64;
        if (l >= 0 && l < a.L) { const size_t off = ((size_t)(l * a.d + a.r) * 1024 + a.h * 128 + ch * 8); kv[it] = *(const u32x4*)(Kb + off); vv[it] = *(const u32x4*)(Vb + off); }
        else { kv[it] = (u32x4){0u, 0u, 0u, 0u}; vv[it] = kv[it]; }
    }
}
__device__ __forceinline__ void a_store(LAS unsigned char* lds, int item, int tid, const float* t5, const u32x4 (&kv)[8], const u32x4 (&vv)[8]) {
    const AItem a = a_decode(item); LAS float* tab = (LAS float*)(lds + LDS_TAB);
#pragma unroll
    for (int it = 0; it < 8; ++it) { const int cid = tid + NTHR * it, row = cid >> 4, ch = cid & 15;
        *(LAS u32x4*)(lds + LDSA_K + row * KSTR + ch * 16) = kv[it]; *(LAS u32x4*)(lds + LDSA_V + row * VSTR + ch * 16) = vv[it]; }
    if (tid < 129) { const int rel = (tid - 64) * a.d; const int n = rel < 0 ? -rel : rel; int bk;
        if (n < 8) bk = n; else { int lg = 8 + (int)(logf((float)n / 8.0f) / 4.852030263919617f * 8.0f); bk = lg < 15 ? lg : 15; }
        if (rel > 0) bk += 16;
        tab[tid] = t5[bk * 8 + a.h] * LOG2E; }
}
__device__ __forceinline__ void a_compute(LAS unsigned char* lds, int item, int tid, const bf16x8 (&qf)[4], float* NUM, float* ML) {
    const int wid = __builtin_amdgcn_readfirstlane(tid >> 6), lane = tid & 63, fr = lane & 15, g = lane >> 4;
    const AItem a = a_decode(item); const int nb = a.nb, L = a.L, d = a.d, r = a.r, h = a.h, b = a.b;
    LAS float* tab = (LAS float*)(lds + LDS_TAB);
    const int i0 = 16 * wid, qi = i0 + fr; const int qpos = (nb * 128 + qi) * d + r;
    f32x4 O[8];
#pragma unroll
    for (int cb = 0; cb < 8; ++cb) O[cb] = (f32x4){0.f, 0.f, 0.f, 0.f};
    float m_run = -1e30f, l_run = 0.f;
    const float scale = 0.08838834764831845f * LOG2E;
    for (int pp = 0; pp < 5; ++pp) {
        const int rowa = i0 + 32 * pp, rowb = rowa + 16;
        f32x4 sa, sb; attn_qk<LDSA_K>(lds, rowa, rowb, qf, lane, sa, sb);
        {
            const int rela = rowa + 4 * g - qi, la = nb * 128 + rowa + 4 * g - 64; float ba[4], bb[4];
#pragma unroll
            for (int j = 0; j < 4; ++j) { int ta = rela + j; ta = ta < 0 ? 0 : (ta > 128 ? 128 : ta); int tb = rela + 16 + j; tb = tb < 0 ? 0 : (tb > 128 ? 128 : tb); ba[j] = tab[ta]; bb[j] = tab[tb]; }
#pragma unroll
            for (int j = 0; j < 4; ++j) {
                const int ra = rela + j, rb = rela + 16 + j, l0 = la + j, l1 = la + 16 + j;
                const bool oka = ((unsigned)ra <= 128u) && ((unsigned)l0 < (unsigned)L), okb = ((unsigned)rb <= 128u) && ((unsigned)l1 < (unsigned)L);
                const float va = fmaf(sa[j], scale, ba[j]), vb = fmaf(sb[j], scale, bb[j]);
                sa[j] = oka ? va : -INFINITY; sb[j] = okb ? vb : -INFINITY;
            }
        }
        attn_pv<LDSA_V>(lds, rowa, rowb, sa, sb, O, m_run, l_run, lane);
    }
    l_run += __shfl_xor(l_run, 16); l_run += __shfl_xor(l_run, 32);
    if (g == 0) { f32x2 ml; ml.x = m_run * LN2; ml.y = l_run; *(f32x2*)(ML + ((size_t)(b * 8 + h) * SEQ + qpos) * 2) = ml; }
    const float inv = 1.0f / l_run;
    store_o_rows((bf16_t*)NUM + ((size_t)b * SEQ + qpos) * 1024 + h * 128, O, inv, g);
}
__device__ __forceinline__ void attn_a_phase(LAS unsigned char* lds, int first, int stride, int count, const bf16_t* Qb, const bf16_t* Kb, const bf16_t* Vb, const float* t5, float* NUM, float* ML) {
    int tid = threadIdx.x; asm volatile("" : "+v"(tid));
    if (count <= 0) return;
    if (tid < 256) { const int row = 256 + (tid >> 4), ch = tid & 15; const u32x4 z = (u32x4){0u, 0u, 0u, 0u};
        *(LAS u32x4*)(lds + LDSA_K + row * KSTR + ch * 16) = z; *(LAS u32x4*)(lds + LDSA_V + row * VSTR + ch * 16) = z; }
    u32x4 kv[8], vv[8];
    a_load(first, tid, Kb, Vb, kv, vv);
    for (int k = 0; k < count; ++k) {
        const int item = first + k * stride;
        a_store(lds, item, tid, t5, kv, vv);
        __syncthreads();
        bf16x8 qf[4];
        { const AItem a = a_decode(item); const int wid = __builtin_amdgcn_readfirstlane(tid >> 6), lane = tid & 63; const int qpos = (a.nb * 128 + 16 * wid + (lane & 15)) * a.d + a.r;
#pragma unroll
          for (int s = 0; s < 4; ++s) qf[s] = *(const bf16x8*)(Qb + (size_t)qpos * 1024 + a.h * 128 + s * 32 + (lane >> 4) * 8); }
        if (k + 1 < count) a_load(item + stride, tid, Kb, Vb, kv, vv);
        a_compute(lds, item, tid, qf, NUM, ML);
        __syncthreads();
    }
}

__device__ __forceinline__ void attn_a_merge(const float* NUM, const float* ML, bf16_t* MG, int first, int stride, int lo, int hi) {
    const bf16_t* NB = (const bf16_t*)NUM;
    for (int it = lo + first; it < hi; it += stride) {
        const int token = it >> 7, c8 = (it & 127) * 8, h = c8 >> 7;
        const f32x2 a = *(const f32x2*)(ML + ((size_t)(0 * 8 + h) * SEQ + token) * 2), b = *(const f32x2*)(ML + ((size_t)(1 * 8 + h) * SEQ + token) * 2), c = *(const f32x2*)(ML + ((size_t)(2 * 8 + h) * SEQ + token) * 2);
        const float M = fmaxf(a.x, fmaxf(b.x, c.x)); float wa = __expf(a.x - M) * a.y, wb = __expf(b.x - M) * b.y, wc = __expf(c.x - M) * c.y;
        const float inv = 1.0f / (wa + wb + wc); wa *= inv; wb *= inv; wc *= inv;
        const u32x4 na = *(const u32x4*)(NB + ((size_t)0 * SEQ + token) * 1024 + c8), nb = *(const u32x4*)(NB + ((size_t)1 * SEQ + token) * 1024 + c8), nc = *(const u32x4*)(NB + ((size_t)2 * SEQ + token) * 1024 + c8);
        u32x4 w;
#pragma unroll
        for (int e = 0; e < 4; ++e) { const float lo_ = bf_lo(na[e]) * wa + bf_lo(nb[e]) * wb + bf_lo(nc[e]) * wc, hi_ = bf_hi(na[e]) * wa + bf_hi(nb[e]) * wb + bf_hi(nc[e]) * wc; w[e] = cvt_pk_bf16(lo_, hi_); }
        *(u32x4*)(MG + (size_t)token * DM + c8) = w;
    }
}

__device__ __forceinline__ int c_rs0(int item) { const int r0 = 2 * (item >> 4); return (r0 - 4) < 0 ? 0 : ((r0 - 4) > 120 ? 120 : (r0 - 4)); }
__device__ __forceinline__ void c_load(int item, int ci, int tid, const bf16_t* Kb, const bf16_t* Vb, u32x4 (&kv)[6], u32x4 (&vv)[6]) {
    const int h = item & 15, rs0 = c_rs0(item);
#pragma unroll
    for (int it = 0; it < 6; ++it) {
        const int cid = tid + NTHR * it, row = cid >> 4, ch = cid & 15; const int kr = rs0 + 3 * ci + (row >> 6), kc = row & 63;
        if (kr < 128) { const size_t off = ((size_t)(kr * 64 + kc) * DM + h * 128 + ch * 8); kv[it] = *(const u32x4*)(Kb + off); vv[it] = *(const u32x4*)(Vb + off); }
        else { kv[it] = (u32x4){0u, 0u, 0u, 0u}; vv[it] = kv[it]; }
    }
}
__device__ __forceinline__ void c_store(LAS unsigned char* lds, int tid, const u32x4 (&kv)[6], const u32x4 (&vv)[6]) {
#pragma unroll
    for (int it = 0; it < 6; ++it) { const int cid = tid + NTHR * it, row = cid >> 4, ch = cid & 15;
        *(LAS u32x4*)(lds + LDSC_K + row * KSTR + ch * 16) = kv[it]; *(LAS u32x4*)(lds + LDSC_V + row * VSTR + ch * 16) = vv[it]; }
}
__device__ __forceinline__ void attn_c_phase(LAS unsigned char* lds, int first, int stride, const bf16_t* Qb, const bf16_t* Kb, const bf16_t* Vb, const float* rpb, bf16_t* MG,
                                             const float* w1s, bf16_t* w1d, const float* w2s, bf16_t* w2d, const float* g1) {
    int tid = threadIdx.x; asm volatile("" : "+v"(tid));
    if (first >= 1024) return;
    const int wid = __builtin_amdgcn_readfirstlane(tid >> 6), lane = tid & 63, fr = lane & 15, g = lane >> 4;
    LAS float* tab = (LAS float*)(lds + LDS_TAB);
    const int rsel = wid >> 2, ct = wid & 3;
    const int colbase = (ct == 0) ? 0 : ((ct == 1) ? 8 : ((ct == 2) ? 24 : 32));
    const int qc = 16 * ct + fr; const int cws = (qc - 8) < 0 ? 0 : ((qc - 8) > 48 ? 48 : (qc - 8));
    const float scale = 0.08838834764831845f * LOG2E;
    u32x4 kv[6], vv[6];
    c_load(first, 0, tid, Kb, Vb, kv, vv);
    bf16x8 qf[4]; f32x4 O[8]; float m_run = -1e30f, l_run = 0.f;
    for (int item = first; item < 1024; item += stride) {
        const int h = item & 15, r0 = 2 * (item >> 4), rs0 = c_rs0(item);
        const int qr = r0 + rsel, token = qr * 64 + qc;
        const int rws = (qr - 4) < 0 ? 0 : ((qr - 4) > 120 ? 120 : (qr - 4));
#pragma unroll
        for (int s = 0; s < 4; ++s) qf[s] = *(const bf16x8*)(Qb + (size_t)token * DM + h * 128 + s * 32 + g * 8);
#pragma unroll
        for (int cb = 0; cb < 8; ++cb) O[cb] = (f32x4){0.f, 0.f, 0.f, 0.f};
        m_run = -1e30f; l_run = 0.f;
        for (int ci = 0; ci < 3; ++ci) {
            c_store(lds, tid, kv, vv);
            if (ci == 0 && tid < 465) tab[tid] = rpb[h * 465 + tid] * LOG2E;
            __syncthreads();
            if (ci < 2) c_load(item, ci + 1, tid, Kb, Vb, kv, vv);
            else if (item + stride < 1024) c_load(item + stride, 0, tid, Kb, Vb, kv, vv);
            f32x4 cv[8]; const int ctile = item * 8 + wid;
            if (ci == 1) conv_issue(w2s, DM, ctile, lane, cv);
            for (int lr = 0; lr < 3; ++lr) {
                const int kr = rs0 + 3 * ci + lr;
                if (kr < rws || kr >= rws + 8) continue;
                const int rowa = lr * 64 + colbase, rowb = rowa + 16;
                f32x4 sa, sb; attn_qk<LDSC_K>(lds, rowa, rowb, qf, lane, sa, sb);
                const int tb = (kr - qr + 7) * 31 + 15 - qc; const int kc0 = colbase + 4 * g; float ba[4], bb[4];
#pragma unroll
                for (int j = 0; j < 4; ++j) { int ta = tb + kc0 + j; ta = ta < 0 ? 0 : (ta > 464 ? 464 : ta); int t2 = tb + kc0 + 16 + j; t2 = t2 < 0 ? 0 : (t2 > 464 ? 464 : t2); ba[j] = tab[ta]; bb[j] = tab[t2]; }
#pragma unroll
                for (int j = 0; j < 4; ++j) {
                    const bool oka = (unsigned)(kc0 + j - cws) < 16u, okb = (unsigned)(kc0 + 16 + j - cws) < 16u;
                    const float va = fmaf(sa[j], scale, ba[j]), vb = fmaf(sb[j], scale, bb[j]);
                    sa[j] = oka ? va : -INFINITY; sb[j] = okb ? vb : -INFINITY;
                }
                attn_pv<LDSC_V>(lds, rowa, rowb, sa, sb, O, m_run, l_run, lane);
            }
            if (ci == 1) conv_finish(w2d, DFF, DM, ctile, lane, cv, nullptr);
            __syncthreads();
        }
        l_run += __shfl_xor(l_run, 16); l_run += __shfl_xor(l_run, 32);
        const float inv = 1.0f / l_run;
        store_o_rows(MG + (size_t)token * DM + h * 128, O, inv, g);
    }
}

__device__ __forceinline__ void s5_gen(LAS unsigned char* lds, const Params& P, int j, int g) {
    const int tid = threadIdx.x;
    LAS f32x2* pw = (LAS f32x2*)lds;
    LAS f32x2* bb = (LAS f32x2*)(lds + 33792);
    LAS f32x2* cc = (LAS f32x2*)(lds + 33792 + 16384);
    LAS float* kern = (LAS float*)(lds + 33792 + 32768);
    const float* lam_re = P.in[4]; const float* lam_im = P.in[5]; const float* log_step = P.in[6];
    const float* b_re = P.in[7]; const float* b_im = P.in[8]; const float* c_re = P.in[9]; const float* c_im = P.in[10]; const float* dsk = P.in[11];
    for (int e = tid; e < 2 * 33 * 64; e += NTHR) {
        const int pp = e & 63, k = (e >> 6) % 33, dir = e / (33 * 64);
        const int idx = ((j * 2 + dir) * 64 + g) * 64 + pp;
        const float step = expf(log_step[(j * 2 + dir) * 64 + g]); const float lr = fminf(lam_re[idx], -1e-4f), li = lam_im[idx];
        const float rho = lr * step, th = li * step; const float mg = expf((float)k * rho); float sn, cs; sincosf((float)k * th, &sn, &cs);
        f32x2 v; v.x = mg * cs; v.y = mg * sn; pw[e] = v;
    }
    if (tid < 128) {
        const int dir = tid >> 6, pp = tid & 63; const int idx = ((j * 2 + dir) * 64 + g) * 64 + pp;
        const double step = exp((double)log_step[(j * 2 + dir) * 64 + g]); const double lr = fmin((double)lam_re[idx], -1e-4), li = (double)lam_im[idx];
        const double mg = exp(lr * step); const double abr = mg * cos(li * step), abi = mg * sin(li * step); const double den = lr * lr + li * li;
        const float zr = (float)(((abr - 1.0) * lr + abi * li) / den), zi = (float)((abi * lr - (abr - 1.0) * li) / den);
        for (int c = 0; c < 16; ++c) { const float br = b_re[((j * 64 + g) * 64 + pp) * 16 + c], bi = b_im[((j * 64 + g) * 64 + pp) * 16 + c];
            f32x2 v; v.x = zr * br - zi * bi; v.y = zr * bi + zi * br; bb[(dir * 64 + pp) * 16 + c] = v; }
        const double mg32 = exp(32.0 * lr * step); f32x2 a32; a32.x = (float)(mg32 * cos(32.0 * li * step)); a32.y = (float)(mg32 * sin(32.0 * li * step));
        *(f32x2*)(P.ws + WS_A32 + (size_t)idx * 8) = a32;
    }
    for (int e = tid; e < 2 * 16 * 64; e += NTHR) { const int dir = e >> 10, rem = e & 1023; const size_t gi = (size_t)((j * 2 + dir) * 64 + g) * 1024 + rem; f32x2 v; v.x = c_re[gi]; v.y = c_im[gi]; cc[e] = v; }
    __syncthreads();
    for (int e = tid; e < 1024; e += NTHR) {
        const int dir = e >> 9, tau = (e >> 4) & 31, co = e & 15; float acc16[16];
#pragma unroll
        for (int ci = 0; ci < 16; ++ci) acc16[ci] = 0.f;
        for (int pp = 0; pp < 64; ++pp) {
            const f32x2 w = pw[(dir * 33 + tau) * 64 + pp], c = cc[(dir * 16 + co) * 64 + pp];
            const float tr = c.x * w.x - c.y * w.y, ti = c.x * w.y + c.y * w.x;
            const LAS f32x4* bp = (const LAS f32x4*)(bb + (dir * 64 + pp) * 16);
#pragma unroll
            for (int q = 0; q < 8; ++q) { const f32x4 b2 = bp[q]; acc16[2 * q] += tr * b2[0] - ti * b2[1]; acc16[2 * q + 1] += tr * b2[2] - ti * b2[3]; }
        }
#pragma unroll
        for (int q = 0; q < 4; ++q) { f32x4 o; o[0] = acc16[4 * q]; o[1] = acc16[4 * q + 1]; o[2] = acc16[4 * q + 2]; o[3] = acc16[4 * q + 3]; *(LAS f32x4*)(kern + e * 16 + 4 * q) = o; }
    }
    __syncthreads();
    bf16_t* B3 = (bf16_t*)(P.ws + WS_B3 + (size_t)j * SZ_B3) + (size_t)g * 512 * 768;
    for (int ch = tid; ch < 512 * 96; ch += NTHR) {
        const int row = ch / 96, kc = (ch % 96) * 8, t = row >> 4, co = row & 15; float v[8];
        if (kc < 512) { const int s = kc >> 4, ci0 = kc & 15; f32x4 a0 = (f32x4){0.f, 0.f, 0.f, 0.f}, a1 = a0;
            if (s <= t) { const LAS f32x4* kp = (const LAS f32x4*)(kern + ((0 * 32 + (t - s)) * 16 + co) * 16 + ci0); a0 += kp[0]; a1 += kp[1]; }
            if (s >= t) { const LAS f32x4* kp = (const LAS f32x4*)(kern + ((1 * 32 + (s - t)) * 16 + co) * 16 + ci0); a0 += kp[0]; a1 += kp[1]; }
#pragma unroll
            for (int e = 0; e < 4; ++e) { v[e] = a0[e]; v[4 + e] = a1[e]; }
            if (s == t && (co >> 3) == (ci0 >> 3)) {
#pragma unroll
                for (int e = 0; e < 8; ++e) if (e == (co & 7)) v[e] += dsk[j * 1024 + 16 * g + co];
            } }
        else { const int kk = kc - 512, dir = kk >> 7, im = (kk >> 6) & 1, p0 = kk & 63; const int ex = (dir == 0) ? (t + 1) : (32 - t);
#pragma unroll
            for (int e = 0; e < 8; ++e) { const int pp = p0 + e; const f32x2 c = cc[(dir * 16 + co) * 64 + pp], w = pw[(dir * 33 + ex) * 64 + pp];
                v[e] = im ? -(c.x * w.y + c.y * w.x) : (c.x * w.x - c.y * w.y); } }
        u32x4 w; w.x = cvt_pk_bf16(v[0], v[1]); w.y = cvt_pk_bf16(v[2], v[3]); w.z = cvt_pk_bf16(v[4], v[5]); w.w = cvt_pk_bf16(v[6], v[7]);
        *(u32x4*)(B3 + (size_t)row * 768 + kc) = w;
    }
    bf16_t* B1 = (bf16_t*)(P.ws + WS_B1 + (size_t)j * SZ_B1) + (size_t)g * 256 * 512;
    for (int ch = tid; ch < 256 * 64; ch += NTHR) {
        const int row = ch >> 6, kc = (ch & 63) * 8, dir = row >> 7, im = (row >> 6) & 1, pp = row & 63, t = kc >> 4, c0 = kc & 15; const int ex = (dir == 0) ? (31 - t) : t;
        const f32x2 w = pw[(dir * 33 + ex) * 64 + pp]; float v[8];
#pragma unroll
        for (int e = 0; e < 8; ++e) { const f32x2 b = bb[(dir * 64 + pp) * 16 + c0 + e]; v[e] = im ? (w.x * b.y + w.y * b.x) : (w.x * b.x - w.y * b.y); }
        u32x4 wv; wv.x = cvt_pk_bf16(v[0], v[1]); wv.y = cvt_pk_bf16(v[2], v[3]); wv.z = cvt_pk_bf16(v[4], v[5]); wv.w = cvt_pk_bf16(v[6], v[7]);
        *(u32x4*)(B1 + (size_t)row * 512 + kc) = wv;
    }
    __syncthreads();
}

__device__ __forceinline__ void s5_carry(LAS unsigned char* lds, const Params& P, int j, int g, int dir) {
    int tid = threadIdx.x; asm volatile("" : "+v"(tid));
    const float* Z = (const float*)(P.ws + WS_Z); bf16_t* U2 = (bf16_t*)(P.ws + WS_U2);
    LAS float* zl = (LAS float*)lds;
#pragma unroll
    for (int it = 0; it < 16; ++it) { const int cid = tid + NTHR * it, n = cid >> 5, c4 = (cid & 31) * 4;
        *(LAS f32x4*)(zl + n * 128 + c4) = *(const f32x4*)(Z + (size_t)(g * 256 + n) * 256 + dir * 128 + c4); }
    __syncthreads();
    if (tid < 64) {
        const int pp = tid; const int idx = ((j * 2 + dir) * 64 + g) * 64 + pp;
        const f32x2 a32 = *(const f32x2*)(P.ws + WS_A32 + (size_t)idx * 8); const float ar = a32.x, ai = a32.y;
        float cr = 0.f, cim = 0.f;
        bf16_t* up = U2 + (size_t)g * 256 * 768 + 512 + dir * 128 + pp;
        for (int s = 0; s < 256; ++s) {
            const int n = dir ? (255 - s) : s;
            up[(size_t)n * 768] = (bf16_t)(cvt_pk_bf16(cr, 0.f) & 0xffffu); up[(size_t)n * 768 + 64] = (bf16_t)(cvt_pk_bf16(cim, 0.f) & 0xffffu);
            const float zr = zl[n * 128 + pp], zi = zl[n * 128 + 64 + pp];
            const float nr = ar * cr - ai * cim + zr, ni = ar * cim + ai * cr + zi; cr = nr; cim = ni;
        }
    }
    __syncthreads();
}

__device__ __forceinline__ void s5_carry2(const Params& P, int j, int g) {
    int tid = threadIdx.x; asm volatile("" : "+v"(tid));
    const int wid = __builtin_amdgcn_readfirstlane(tid >> 6), pp = tid & 63;
    if (wid < 2) {
        const int dir = wid; const int idx = ((j * 2 + dir) * 64 + g) * 64 + pp;
        const f32x2 a32 = *(const f32x2*)(P.ws + WS_A32 + (size_t)idx * 8); const float ar = a32.x, ai = a32.y;
        const float* zp = (const float*)(P.ws + WS_Z) + (size_t)(g * 256) * 256 + dir * 128 + pp;
        bf16_t* up = (bf16_t*)(P.ws + WS_U2) + (size_t)g * 256 * 768 + 512 + dir * 128 + pp;
        float cr = 0.f, cim = 0.f; float zr[8], zi[8], nzr[8], nzi[8];
#pragma unroll
        for (int u = 0; u < 8; ++u) { const int n = dir ? (255 - u) : u; zr[u] = zp[(size_t)n * 256]; zi[u] = zp[(size_t)n * 256 + 64]; }
        for (int s0 = 0; s0 < 256; s0 += 8) {
            if (s0 + 8 < 256) {
#pragma unroll
                for (int u = 0; u < 8; ++u) { const int n = dir ? (255 - (s0 + 8 + u)) : (s0 + 8 + u); nzr[u] = zp[(size_t)n * 256]; nzi[u] = zp[(size_t)n * 256 + 64]; }
            }
#pragma unroll
            for (int u = 0; u < 8; ++u) { const int n = dir ? (255 - (s0 + u)) : (s0 + u);
                up[(size_t)n * 768] = (bf16_t)(cvt_pk_bf16(cr, 0.f) & 0xffffu); up[(size_t)n * 768 + 64] = (bf16_t)(cvt_pk_bf16(cim, 0.f) & 0xffffu);
                const float nr = ar * cr - ai * cim + zr[u], ni = ar * cim + ai * cr + zi[u]; cr = nr; cim = ni; }
#pragma unroll
            for (int u = 0; u < 8; ++u) { zr[u] = nzr[u]; zi[u] = nzi[u]; }
        }
    }
    __syncthreads();
}

__device__ __forceinline__ void conv_tile(const float* src, bf16_t* dst, int K, int N, int tile, int lane, const float* gk) {
    const int tn = N >> 5; const int k0 = (tile / tn) * 64, n0 = (tile % tn) * 32; const int kg = lane & 7, jn = lane >> 3;
    f32x4 v[8]; const float* sp = src + (size_t)(k0 + 8 * kg) * N + n0 + 4 * jn;
#pragma unroll
    for (int r = 0; r < 8; ++r) v[r] = *(const f32x4*)(sp + (size_t)r * N);
    if (gk) { const f32x4 g0 = *(const f32x4*)(gk + k0 + 8 * kg), g1 = *(const f32x4*)(gk + k0 + 8 * kg + 4);
#pragma unroll
        for (int r = 0; r < 4; ++r) { v[r] *= g0[r]; v[4 + r] *= g1[r]; } }
#pragma unroll
    for (int i = 0; i < 4; ++i) { u32x4 w; w.x = cvt_pk_bf16(v[0][i], v[1][i]); w.y = cvt_pk_bf16(v[2][i], v[3][i]); w.z = cvt_pk_bf16(v[4][i], v[5][i]); w.w = cvt_pk_bf16(v[6][i], v[7][i]);
        *(u32x4*)(dst + (size_t)(n0 + 4 * jn + i) * K + k0 + 8 * kg) = w; }
}
constexpr int T_WIN = 4096, T_WOUT = 2048, T_GLU = 512, T_QKV = 6144, T_W1 = 8192, T_W2 = 8192;
constexpr int T_EVEN = T_WIN + T_WOUT + T_GLU + T_W1 + T_W2, T_ODD = T_QKV + T_WOUT + T_W1 + T_W2, T_PAIR = T_EVEN + T_ODD, T_ALL = 2 * T_PAIR;
__device__ __forceinline__ void conv_dispatch(const Params& P, int tile, int lane) {
    const int j = tile / T_PAIR; int rem = tile % T_PAIR; unsigned char* ws = P.ws;
    if (rem < T_EVEN) { const int i = 2 * j;
        if (rem < T_WIN) { conv_tile(P.in[2] + (size_t)j * 2048 * 4096, (bf16_t*)(ws + WS_WIN + j * SZ_WIN), 2048, 4096, rem, lane, P.in[16] + (size_t)i * DM); return; } rem -= T_WIN;
        if (rem < T_WOUT) { conv_tile(P.in[3] + (size_t)j * 2048 * 2048, (bf16_t*)(ws + WS_WOUT + j * SZ_WOUT), 2048, 2048, rem, lane, nullptr); return; } rem -= T_WOUT;
        if (rem < T_GLU) { conv_tile(P.in[12] + (size_t)j * 1024 * 1024, (bf16_t*)(ws + WS_GLU + j * SZ_GLU), 1024, 1024, rem, lane, nullptr); return; } rem -= T_GLU;
        if (rem < T_W1) { conv_tile(P.in[18] + (size_t)i * 2048 * 8192, (bf16_t*)(ws + WS_W1 + i * SZ_W1), 2048, 8192, rem, lane, P.in[17] + (size_t)i * DM); return; } rem -= T_W1;
        conv_tile(P.in[19] + (size_t)i * 8192 * 2048, (bf16_t*)(ws + WS_W2 + i * SZ_W2), 8192, 2048, rem, lane, nullptr);
    } else { rem -= T_EVEN; const int i = 2 * j + 1;
        if (rem < T_QKV) { conv_tile(P.in[13] + (size_t)j * 2048 * 6144, (bf16_t*)(ws + WS_QKV + j * SZ_QKV), 2048, 6144, rem, lane, P.in[16] + (size_t)i * DM); return; } rem -= T_QKV;
        if (rem < T_WOUT) { conv_tile(P.in[14] + (size_t)j * 2048 * 2048, (bf16_t*)(ws + WS_COUT + j * SZ_WOUT), 2048, 2048, rem, lane, nullptr); return; } rem -= T_WOUT;
        if (rem < T_W1) { conv_tile(P.in[18] + (size_t)i * 2048 * 8192, (bf16_t*)(ws + WS_W1 + i * SZ_W1), 2048, 8192, rem, lane, P.in[17] + (size_t)i * DM); return; } rem -= T_W1;
        conv_tile(P.in[19] + (size_t)i * 8192 * 2048, (bf16_t*)(ws + WS_W2 + i * SZ_W2), 8192, 2048, rem, lane, nullptr);
    }
}

#define XB_TMO      128
#define XB_XCNT(j)  (256  + 64 * (j))
#define XB_XSUB(j)  (1280 + 64 * (j))
#define XB_XGEN(j)  (2304 + 64 * (j))
#define XB_TOP      3328
#define XB_TOPGEN   3392
#define XCD_BAR_WORDS 3456
#define XB_SPIN_CAP (1u << 18)
__device__ __forceinline__ unsigned xb_ld(unsigned* p)              { return __hip_atomic_load(p, __ATOMIC_RELAXED, __HIP_MEMORY_SCOPE_AGENT); }
__device__ __forceinline__ unsigned xb_add(unsigned* p, unsigned v) { return __hip_atomic_fetch_add(p, v, __ATOMIC_RELAXED, __HIP_MEMORY_SCOPE_AGENT); }
__device__ __forceinline__ unsigned xb_xcc_id() { return (unsigned)__builtin_amdgcn_s_getreg((3 << 11) | 20) & 0xFu; }
#define XB_SPIN(cond, bar) do { unsigned _sp = 0; while (cond) { __builtin_amdgcn_s_sleep(1); \
    if ((++_sp & 255u) == 0u) { if (xb_ld(&(bar)[XB_TMO])) break; if (_sp > XB_SPIN_CAP) { atomicAdd(&(bar)[XB_TMO], 1u); break; } } } } while (0)
struct XcdBarrier { unsigned* bar; unsigned x; volatile LAS unsigned* st; };
__device__ __forceinline__ XcdBarrier xcd_barrier_post(unsigned* bar, volatile LAS unsigned* st) {
    XcdBarrier b; b.bar = bar; b.x = xb_xcc_id(); b.st = st;
    if (threadIdx.x == 0) (void)xb_add(&bar[XB_XCNT(b.x)], 1u);
    return b;
}
__device__ __forceinline__ void xcd_barrier_complete(unsigned* bar, unsigned x, unsigned& nloc, unsigned& nx) {
    const unsigned G = gridDim.x * gridDim.y * gridDim.z;
    unsigned sum, cnt, mine, sp = 0u;
    for (;;) {
        sum = 0u; cnt = 0u; mine = 0u;
#pragma unroll
        for (unsigned j = 0; j < 16; ++j) { const unsigned c = xb_ld(&bar[XB_XCNT(j)]); sum += c; cnt += (c > 0u) ? 1u : 0u; mine = (j == x) ? c : mine; }
        if (sum == G) break;
        __builtin_amdgcn_s_sleep(1);
        if ((++sp & 255u) == 0u) { if (xb_ld(&bar[XB_TMO])) break; if (sp > XB_SPIN_CAP) { atomicAdd(&bar[XB_TMO], 1u); break; } }
    }
    nloc = mine > 0u ? mine : 1u; nx = cnt > 0u ? cnt : 1u;
}
__device__ __forceinline__ void xcd_barrier(const XcdBarrier& b) {
    asm volatile("s_waitcnt vmcnt(0)" ::: "memory");
    __syncthreads();
    if (threadIdx.x == 0) {
        unsigned* bar = b.bar;
        __builtin_amdgcn_s_waitcnt(0);
        unsigned nloc = b.st[0], nx = b.st[1];
        if (nloc == 0u) { xcd_barrier_complete(bar, b.x, nloc, nx); b.st[0] = nloc; b.st[1] = nx; }
        const unsigned old = xb_add(&bar[XB_XSUB(b.x)], 1u);
        const unsigned gen = old / nloc;
        if (old + 1u == (gen + 1u) * nloc) {
            __builtin_amdgcn_fence(__ATOMIC_RELEASE, "agent");
            asm volatile("s_waitcnt vmcnt(0)" ::: "memory");
            const unsigned og = xb_add(&bar[XB_TOP], 1u);
            const unsigned tg = og / nx;
            if (og + 1u == (tg + 1u) * nx) xb_add(&bar[XB_TOPGEN], 1u);
            else XB_SPIN(xb_ld(&bar[XB_TOPGEN]) == tg, bar);
            __builtin_amdgcn_fence(__ATOMIC_ACQUIRE, "agent");
            xb_add(&bar[XB_XGEN(b.x)], 1u);
            asm volatile("s_waitcnt vmcnt(0)" ::: "memory");
        } else {
            XB_SPIN(xb_ld(&bar[XB_XGEN(b.x)]) == gen, bar);
            __builtin_amdgcn_fence(__ATOMIC_ACQUIRE, "agent");
            asm volatile("s_waitcnt vmcnt(0)" ::: "memory");
        }
    }
    __syncthreads();
}
constexpr int MERGE_ITEMS = SEQ * 128, MERGE_SPLIT = (MERGE_ITEMS / 16) * 7;
constexpr int LDS_XB = LDS_BYTES - 16;

__global__ void __launch_bounds__(NTHR) hybrid_encoder_fwd(Params P) {
    extern __shared__ __attribute__((aligned(16))) unsigned char lds_raw[];
    LAS unsigned char* lds = (LAS unsigned char*)lds_raw;
    cg::grid_group grid = cg::this_grid();
    if (threadIdx.x == 0) { *(volatile LAS unsigned*)(lds + LDS_XB) = 0u; *(volatile LAS unsigned*)(lds + LDS_XB + 4) = 0u; }
    __syncthreads();
    const XcdBarrier xb = xcd_barrier_post((unsigned*)P.ws, (volatile LAS unsigned*)(lds + LDS_XB));
    const int tid = threadIdx.x, lane = tid & 63, wid = __builtin_amdgcn_readfirstlane(tid >> 6);
    const int bid = blockIdx.x, G = gridDim.x;
    unsigned char* ws = P.ws;
    bf16_t* XG = (bf16_t*)(ws + WS_XG);
    bf16_t* Qb = (bf16_t*)(ws + WS_Q); bf16_t* Kb = (bf16_t*)(ws + WS_K); bf16_t* Vb = (bf16_t*)(ws + WS_V);
    bf16_t* U2 = (bf16_t*)(ws + WS_U2); float* Z = (float*)(ws + WS_Z); bf16_t* Y = (bf16_t*)(ws + WS_Y); bf16_t* MG = (bf16_t*)(ws + WS_MG);
    bf16_t* H = (bf16_t*)(ws + WS_H); float* NUM = (float*)(ws + WS_NUM); float* ML = (float*)(ws + WS_ML); float* SSQ = (float*)(ws + WS_SSQ);
#define GSYNC0() do { asm volatile("s_waitcnt vmcnt(0) lgkmcnt(0)" ::: "memory"); grid.sync(); } while (0)
#define GSYNC() xcd_barrier(xb)

    {
        {
            const float* x = P.in[0];
            for (int row = bid * 8 + wid; row < SEQ; row += G * 8) {
                float ss = 0.f;
#pragma unroll
                for (int i = 0; i < 8; ++i) { const int c = lane * 4 + 256 * i; const f32x4 v = *(const f32x4*)(x + (size_t)row * DM + c);
                    u32x2 w; w.x = cvt_pk_bf16(v[0], v[1]); w.y = cvt_pk_bf16(v[2], v[3]);
                    const float r0 = bf_lo(w.x), r1 = bf_hi(w.x), r2 = bf_lo(w.y), r3 = bf_hi(w.y); ss += (r0 * r0 + r1 * r1) + (r2 * r2 + r3 * r3);
                    *(u32x2*)(XG + (size_t)row * DM + c) = w; }
                ss += __shfl_xor(ss, 32);
                if (lane < 32) SSQ[(size_t)row * 32 + lane] = ss;
            }
        }
        for (int it = bid; it < 128; it += G) { s5_gen(lds, P, it >> 6, it & 63);
        }
        {
            constexpr int PB_PAIR = (T_PAIR - T_W2) / 4, NBATCH = 2 * PB_PAIR, NB1 = 14848;
#define PREP_TILE(bt) (((bt) / PB_PAIR) * T_PAIR + ((bt) % PB_PAIR) * 4)
            if (bid >= 128) for (int bt = (bid - 128) * 8 + wid; bt < NB1; bt += (G - 128) * 8) {
#pragma unroll 1
                for (int q = 0; q < 4; ++q) conv_dispatch(P, PREP_TILE(bt) + q, lane); }
            for (int bt = NB1 + bid * 8 + wid; bt < NBATCH; bt += G * 8) {
#pragma unroll 1
                for (int q = 0; q < 4; ++q) conv_dispatch(P, PREP_TILE(bt) + q, lane); }
#undef PREP_TILE
        }
    }
    GSYNC0();

    for (int layer = 0; layer < 4; ++layer) {
        const int j = layer >> 1; const bool odd = layer & 1;
        const float* ssq_mix = SSQ + (size_t)(2 * layer) * SEQ * 32; float* ssq_mlp = SSQ + (size_t)(2 * layer + 1) * SEQ * 32; float* ssq_nxt = SSQ + (size_t)(2 * layer + 2) * SEQ * 32;
        {
            Gemm gm; gm.A = XG; gm.Bt = odd ? (const bf16_t*)(ws + WS_QKV + j * SZ_QKV) : (const bf16_t*)(ws + WS_WIN + j * SZ_WIN); gm.lda = DM; gm.ldb = DM; gm.K = DM;
            StaticOrder S; S.init(SEQ, odd ? 6144 : 4096, G, bid);
            EpiIn E; E.Q = Qb; E.K = Kb; E.V = Vb; E.U2 = U2; E.ssq = ssq_mix; E.shift = odd ? 11 : 10; E.ldq = odd ? 2048 : 1024;
            gemm_phase<EpiIn, StaticOrder>(lds, gm, S, E);
        }
        GSYNC();
        if (!odd) {
            {
                Gemm gm; gm.A = U2; gm.Bt = (const bf16_t*)(ws + WS_B1 + j * SZ_B1); gm.lda = 768; gm.ldb = 512; gm.K = 512;
                ListOrder S; S.total = 64; S.G = 64; S.c = bid; S.mode = 0;
                EpiP1 E; E.Z = Z;
                gemm_phase<EpiP1, ListOrder>(lds, gm, S, E);
                if (bid < 64) {
                    asm volatile("s_waitcnt vmcnt(0)" ::: "memory"); __syncthreads();
                    __builtin_amdgcn_fence(__ATOMIC_ACQUIRE, "agent"); asm volatile("s_waitcnt vmcnt(0)" ::: "memory");
                    s5_carry2(P, j, bid);
                    asm volatile("s_waitcnt vmcnt(0)" ::: "memory"); __syncthreads();
                    __builtin_amdgcn_fence(__ATOMIC_ACQUIRE, "agent"); asm volatile("s_waitcnt vmcnt(0)" ::: "memory"); __syncthreads();
                    Gemm g3; g3.A = U2; g3.Bt = (const bf16_t*)(ws + WS_B3 + j * SZ_B3); g3.lda = 768; g3.ldb = 768; g3.K = 768;
                    ListOrder S3; S3.total = 128; S3.G = 64; S3.c = bid; S3.mode = 2;
                    EpiP3 E3; E3.Y = Y;
                    gemm_phase<EpiP3, ListOrder>(lds, g3, S3, E3);
                } else {
                    attn_a_phase(lds, bid - 64, 192, 8, Qb, Kb, Vb, P.in[1], NUM, ML);
                }
            }
            GSYNC();
            {
                Gemm gm; gm.A = Y; gm.Bt = (const bf16_t*)(ws + WS_GLU + j * SZ_GLU); gm.lda = 1024; gm.ldb = 1024; gm.K = 1024;
                StaticOrder S; S.init(SEQ, 1024, G, bid);
                EpiGlu E; E.Y = Y; E.MG = MG;
                gemm_phase<EpiGlu, StaticOrder>(lds, gm, S, E);
                if (bid >= 128) attn_a_merge(NUM, ML, MG, (bid - 128) * NTHR + tid, 128 * NTHR, 0, MERGE_ITEMS);
            }
            GSYNC();
        } else {
            attn_c_phase(lds, bid, G, Qb, Kb, Vb, P.in[15] + (size_t)j * 16 * 465, MG,
                         P.in[18] + (size_t)layer * 2048 * 8192, (bf16_t*)(ws + WS_W1 + layer * SZ_W1), P.in[19] + (size_t)layer * 8192 * 2048, (bf16_t*)(ws + WS_W2 + layer * SZ_W2), P.in[17] + (size_t)layer * DM);
            GSYNC();
        }
        {
            Gemm gm; gm.A = MG; gm.Bt = odd ? (const bf16_t*)(ws + WS_COUT + j * SZ_WOUT) : (const bf16_t*)(ws + WS_WOUT + j * SZ_WOUT); gm.lda = DM; gm.ldb = DM; gm.K = DM;
            StaticOrder S; S.init(SEQ, DM, G, bid);
            EpiRes E; E.XB = XG; E.ssq_next = ssq_mlp;
            gemm_phase<EpiRes, StaticOrder>(lds, gm, S, E);
        }
        GSYNC();
        {
            Gemm gm; gm.A = XG; gm.Bt = (const bf16_t*)(ws + WS_W1 + layer * SZ_W1); gm.lda = DM; gm.ldb = DM; gm.K = DM;
            StaticOrder S; S.init(SEQ, DFF, G, bid);
            EpiH E; E.H = H; E.ssq = ssq_mlp;
            gemm_phase<EpiH, StaticOrder>(lds, gm, S, E);
        }
        GSYNC();
        {
            Gemm gm; gm.A = H; gm.Bt = (const bf16_t*)(ws + WS_W2 + layer * SZ_W2); gm.lda = DFF; gm.ldb = DFF; gm.K = DFF;
            StaticOrder S; S.init(SEQ, DM, G, bid);
            EpiRes E; E.XB = XG; E.ssq_next = ssq_nxt;
            gemm_phase<EpiRes, StaticOrder>(lds, gm, S, E);
        }
        GSYNC();
    }
    {
        const float* ssq = SSQ + (size_t)8 * SEQ * 32; const float* gf = P.in[20];
        for (int row = bid * 8 + wid; row < SEQ; row += G * 8) {
            const float rs = row_rstd(ssq, row);
#pragma unroll
            for (int i = 0; i < 8; ++i) { const int c = lane * 4 + 256 * i;
                const u32x2 xw = *(const u32x2*)(XG + (size_t)row * DM + c); const f32x4 gv = *(const f32x4*)(gf + c);
                f32x4 v; v[0] = bf_lo(xw.x); v[1] = bf_hi(xw.x); v[2] = bf_lo(xw.y); v[3] = bf_hi(xw.y);
                *(f32x4*)(P.out + (size_t)row * DM + c) = v * rs * gv; }
        }
    }
}

extern "C" void kernel_launch(void* const* d_in, const int* in_sizes, int n_in, void* d_out, int out_size, void* d_ws, size_t ws_size, hipStream_t stream) {
    static int grid = 0;
    if (grid == 0) {
        if (n_in != 21 || ws_size < WS_END) { fprintf(stderr, "kernel_launch: need 21 inputs and %zu bytes of workspace (got %d, %zu)\n", (size_t)WS_END, n_in, ws_size); grid = -1; return; }
        int dev = 0, cus = 0, per_cu = 0;
        hipGetDevice(&dev); hipDeviceGetAttribute(&cus, hipDeviceAttributeMultiprocessorCount, dev);
        if (hipFuncSetAttribute((const void*)hybrid_encoder_fwd, hipFuncAttributeMaxDynamicSharedMemorySize, LDS_BYTES) != hipSuccess) { fprintf(stderr, "kernel_launch: hipFuncSetAttribute failed\n"); grid = -1; return; }
        if (hipOccupancyMaxActiveBlocksPerMultiprocessor(&per_cu, (const void*)hybrid_encoder_fwd, NTHR, LDS_BYTES) != hipSuccess || per_cu < 1) { fprintf(stderr, "kernel_launch: occupancy query says %d blocks/CU\n", per_cu); per_cu = 1; }
        (void)hipGetLastError();
        grid = cus;
    }
    if (grid < 0) return;
    hipMemsetAsync((char*)d_ws + WS_CTRL, 0, 16384, stream);
    Params p{};
    for (int i = 0; i < 21; ++i) p.in[i] = (const float*)d_in[i];
    p.out = (float*)d_out; p.ws = (unsigned char*)d_ws; p.coop = 1; p.pad = 0;
    void* args[] = {&p};
    hipError_t e = hipLaunchCooperativeKernel((const void*)hybrid_encoder_fwd, dim3(grid), dim3(NTHR), args, LDS_BYTES, stream);
    if (e != hipSuccess) fprintf(stderr, "cooperative launch failed: %s (grid %d)\n", hipGetErrorString(e), grid);
}
```
